# Optimizing an MI355X kernel written in HIP

```python
import jax, jax.numpy as jnp
from jax import lax
import numpy as np


D_MODEL = 2048
BATCH = 4
SEQ = 2048
DEPTH = 4

GRID_W = 64
CTX_LEN = 256
HEAD_DIM = 128
N_HEADS = D_MODEL // 2 // HEAD_DIM
N_KV_HEADS = N_HEADS // 4
GROUP = N_HEADS // N_KV_HEADS
WINDOW = 128
BLOCK = 128
ROPE_THETA = 10000.0
ROPE_AXIS = HEAD_DIM // 2
POOL_GROUPS = 4
POOL_CH = D_MODEL // 4 // POOL_GROUPS
POOL_WINDOWS = (2, 4, 8, 16)
SGU_GROUPS = 4
SGU_CH = D_MODEL // 4 // SGU_GROUPS
CHUNK = 128
Q_W = N_HEADS * HEAD_DIM
KV_W = N_KV_HEADS * HEAD_DIM
POOL_W = POOL_GROUPS * POOL_CH
SGU_W = SGU_GROUPS * SGU_CH
MIX_W = Q_W + POOL_W + SGU_W
IN_W = Q_W + 2 * KV_W + POOL_W + 2 * SGU_W
D_FF = -(-8 * D_MODEL // (3 * 256)) * 256
EPS = 1e-6

kernel_name = "hybrid_parallel_group_dit_block"


def rms_norm(x, g):
    xf = x.astype(jnp.float32)
    y = xf * lax.rsqrt(jnp.mean(xf * xf, axis=-1, keepdims=True) + EPS)
    return (y * g.astype(jnp.float32)).astype(x.dtype)


def layer_norm(x, g):
    xf = x.astype(jnp.float32)
    mu = jnp.mean(xf, axis=-1, keepdims=True)
    var = jnp.mean(jnp.square(xf - mu), axis=-1, keepdims=True)
    return ((xf - mu) * lax.rsqrt(var + EPS) * g.astype(jnp.float32)).astype(x.dtype)


def modulate(h, shift, scale):
    return h * (1 + scale) + shift


def axial_rope_tables(rows):
    inv_freq = ROPE_THETA ** (-jnp.arange(0, ROPE_AXIS, 2, dtype=jnp.float32) / ROPE_AXIS)
    row = jnp.repeat(jnp.arange(rows, dtype=jnp.float32), GRID_W)
    col = jnp.tile(jnp.arange(GRID_W, dtype=jnp.float32), rows)
    ang = jnp.stack([row[:, None] * inv_freq, col[:, None] * inv_freq], axis=1)
    return jnp.cos(ang), jnp.sin(ang)


def apply_rope(x, cos, sin):
    B, S, H, _ = x.shape
    xr = x.reshape(B, S, H, 2, 2, ROPE_AXIS // 2).astype(jnp.float32)
    x1, x2 = xr[..., 0, :], xr[..., 1, :]
    c = cos[None, :, None]
    s = sin[None, :, None]
    out = jnp.stack([x1 * c - x2 * s, x2 * c + x1 * s], axis=-2)
    return out.reshape(B, S, H, HEAD_DIM).astype(x.dtype)


def split_in(p):
    B, S = p.shape[:2]
    q = p[..., :Q_W].reshape(B, S, N_HEADS, HEAD_DIM)
    k = p[..., Q_W:Q_W + KV_W].reshape(B, S, N_KV_HEADS, HEAD_DIM)
    v = p[..., Q_W + KV_W:Q_W + 2 * KV_W].reshape(B, S, N_KV_HEADS, HEAD_DIM)
    o = Q_W + 2 * KV_W
    pool_in = p[..., o:o + POOL_W]
    u = p[..., o + POOL_W:o + POOL_W + SGU_W]
    z = p[..., o + POOL_W + SGU_W:]
    return q, k, v, pool_in, u, z


def sink_column(sink, shape):
    s = sink.astype(jnp.float32).reshape(N_KV_HEADS, GROUP)
    return jnp.broadcast_to(s[:, :, None, None], shape[:-1] + (1,))


def window_attention(q, k, v, kc, vc, sink):
    B, S = q.shape[:2]
    nb = S // BLOCK
    scale = HEAD_DIM ** -0.5
    qb = q.reshape(B, nb, BLOCK, N_KV_HEADS, GROUP, HEAD_DIM)
    pad = ((0, 0), (BLOCK, BLOCK), (0, 0), (0, 0))
    kp = jnp.pad(k, pad).reshape(B, nb + 2, BLOCK, N_KV_HEADS, HEAD_DIM)
    vp = jnp.pad(v, pad).reshape(B, nb + 2, BLOCK, N_KV_HEADS, HEAD_DIM)
    kb = jnp.concatenate([kp[:, :-2], kp[:, 1:-1], kp[:, 2:]], axis=2)
    vb = jnp.concatenate([vp[:, :-2], vp[:, 1:-1], vp[:, 2:]], axis=2)
    s_loc = jnp.einsum('bnqhgd,bnkhd->bnhgqk', qb, kb).astype(jnp.float32) * scale
    s_ctx = jnp.einsum('bnqhgd,bchd->bnhgqc', qb, kc).astype(jnp.float32) * scale
    qi = jnp.arange(BLOCK)
    kj = jnp.arange(3 * BLOCK)
    rel = kj[None, :] - BLOCK - qi[:, None]
    key_pos = jnp.arange(nb)[:, None] * BLOCK - BLOCK + kj[None, :]
    mask = (jnp.abs(rel) <= WINDOW)[None] & ((key_pos >= 0) & (key_pos < S))[:, None, :]
    s_loc = jnp.where(mask[None, :, None, None], s_loc, -jnp.inf)
    sink_l = jnp.broadcast_to(sink.astype(jnp.float32).reshape(N_KV_HEADS, GROUP)[None, None, :, :, None, None],
                              s_loc.shape[:-1] + (1,))
    p = jax.nn.softmax(jnp.concatenate([s_loc, s_ctx, sink_l], axis=-1), axis=-1)
    nk = 3 * BLOCK
    nc = kc.shape[1]
    p_loc = p[..., :nk].astype(v.dtype)
    p_ctx = p[..., nk:nk + nc].astype(v.dtype)
    out = (jnp.einsum('bnhgqk,bnkhd->bnqhgd', p_loc, vb)
           + jnp.einsum('bnhgqc,bchd->bnqhgd', p_ctx, vc))
    return out.reshape(B, S, Q_W)


def context_attention(q, k, v, sink):
    B, C = q.shape[:2]
    qg = q.reshape(B, C, N_KV_HEADS, GROUP, HEAD_DIM)
    s = jnp.einsum('bqhgd,bkhd->bhgqk', qg, k).astype(jnp.float32) * HEAD_DIM ** -0.5
    sink_c = jnp.broadcast_to(sink.astype(jnp.float32).reshape(N_KV_HEADS, GROUP)[None, :, :, None, None],
                              s.shape[:-1] + (1,))
    p = jax.nn.softmax(jnp.concatenate([s, sink_c], axis=-1), axis=-1)[..., :C].astype(v.dtype)
    out = jnp.einsum('bhgqk,bkhd->bqhgd', p, v)
    return out.reshape(B, C, Q_W)


def pool_mixer(p, w, ch_scale):
    B, S = p.shape[:2]
    pg = p.reshape(B, S, POOL_GROUPS, POOL_CH)
    pf = pg.astype(jnp.float32)
    cs = jnp.concatenate([jnp.zeros((B, 1, POOL_GROUPS, POOL_CH), jnp.float32),
                          jnp.cumsum(pf, axis=1)], axis=1)
    half = jnp.array(POOL_WINDOWS, dtype=jnp.int32) // 2
    t = jnp.arange(S, dtype=jnp.int32)[:, None]
    lo = jnp.clip(t - half[None, :], 0, S)
    hi = jnp.clip(t + half[None, :], 0, S)
    gidx = jnp.arange(POOL_GROUPS)[None, :]
    win_sum = cs[:, hi, gidx, :] - cs[:, lo, gidx, :]
    cnt = (hi - lo).astype(jnp.float32)[None, :, :, None]
    pooled = (win_sum / cnt - pf).astype(p.dtype)
    out = jnp.einsum('bsgc,gcd->bsgd', pooled, w) * ch_scale.reshape(POOL_GROUPS, POOL_CH)
    return out.reshape(B, S, POOL_W)


def sgu_mixer(u, z, norm_g, w_s, b_s):
    B, S = u.shape[:2]
    n = S // CHUNK
    u = jax.nn.gelu(u, approximate=False).reshape(B, n, CHUNK, SGU_GROUPS, SGU_CH)
    z = jax.nn.gelu(z, approximate=False).reshape(B, S, SGU_GROUPS, SGU_CH)
    z = layer_norm(z, norm_g).reshape(B, n, CHUNK, SGU_GROUPS, SGU_CH)
    mixed = jnp.einsum('gpq,bnqgc->bnpgc', w_s, z) + b_s.T[None, None, :, :, None]
    return (u * mixed).reshape(B, S, SGU_W)


def swiglu(h, w_gu, w_dn):
    g, up = jnp.split(h @ w_gu, 2, axis=-1)
    return (jax.nn.silu(g) * up) @ w_dn


def setup_inputs(seed: int = 0) -> dict:
    key = jax.random.key(seed)
    ks = jax.random.split(key, 19)
    f = jnp.float32
    nrm = lambda k, shape, s: jax.random.normal(k, shape, f) * s
    return {
        "x": nrm(ks[0], (BATCH, SEQ, D_MODEL), 1.0),
        "c": nrm(ks[1], (BATCH, D_MODEL), 1.0),
        "ctx": nrm(ks[2], (BATCH, CTX_LEN, D_MODEL), 1.0),
        "c_ctx": nrm(ks[3], (D_MODEL,), 1.0),
        "w_ada": nrm(ks[4], (DEPTH, D_MODEL, 6 * D_MODEL), 0.5 * D_MODEL ** -0.5),
        "b_ada": nrm(ks[5], (DEPTH, 6 * D_MODEL), 0.01),
        "norm_mix_g": 1.0 + nrm(ks[6], (DEPTH, D_MODEL), 0.02),
        "norm_ffn_g": 1.0 + nrm(ks[7], (DEPTH, D_MODEL), 0.02),
        "w_in": nrm(ks[8], (DEPTH, D_MODEL, IN_W), D_MODEL ** -0.5),
        "attn_sink": nrm(ks[9], (DEPTH, N_HEADS), 0.5),
        "pool_w": nrm(ks[10], (DEPTH, POOL_GROUPS, POOL_CH, POOL_CH), POOL_CH ** -0.5),
        "pool_scale": 1.0 + nrm(ks[11], (DEPTH, POOL_W), 0.02),
        "sgu_norm_g": 1.0 + nrm(ks[12], (DEPTH, SGU_GROUPS, SGU_CH), 0.02),
        "sgu_w": nrm(ks[13], (DEPTH, SGU_GROUPS, CHUNK, CHUNK), CHUNK ** -0.5),
        "sgu_b": 1.0 + nrm(ks[14], (DEPTH, SGU_GROUPS, CHUNK), 0.02),
        "w_out": nrm(ks[15], (DEPTH, MIX_W, D_MODEL), MIX_W ** -0.5),
        "w_gate_up": nrm(ks[16], (DEPTH, D_MODEL, 2 * D_FF), D_MODEL ** -0.5),
        "w_down": nrm(ks[17], (DEPTH, D_FF, D_MODEL), D_FF ** -0.5),
        "final_norm_g": 1.0 + nrm(ks[18], (D_MODEL,), 0.02),
    }


def reference(x, c, ctx, c_ctx, w_ada, b_ada, norm_mix_g, norm_ffn_g, w_in, attn_sink, pool_w, pool_scale,
              sgu_norm_g, sgu_w, sgu_b, w_out, w_gate_up, w_down, final_norm_g):
    B = x.shape[0]
    C = ctx.shape[1]
    rows = x.shape[1] // GRID_W
    cos, sin = axial_rope_tables(rows)
    silu_c = jax.nn.silu(c)
    silu_cc = jax.nn.silu(c_ctx)
    h_ctx = ctx
    for l in range(DEPTH):
        last = l == DEPTH - 1
        mx = jnp.split((silu_c @ w_ada[l] + b_ada[l])[:, None, :], 6, axis=-1)
        mc = jnp.split(silu_cc @ w_ada[l] + b_ada[l], 6, axis=-1)
        hc = modulate(rms_norm(h_ctx, norm_mix_g[l]), mc[0], mc[1])
        if last:
            kc, vc = jnp.split(hc @ w_in[l][:, Q_W:Q_W + 2 * KV_W], 2, axis=-1)
            kc = kc.reshape(B, C, N_KV_HEADS, HEAD_DIM)
            vc = vc.reshape(B, C, N_KV_HEADS, HEAD_DIM)
        else:
            qc, kc, vc, poolc, uc, zc = split_in(hc @ w_in[l])
        hx = modulate(rms_norm(x, norm_mix_g[l]), mx[0], mx[1])
        qx, kx, vx, poolx, ux, zx = split_in(hx @ w_in[l])
        qx = apply_rope(qx, cos, sin)
        kx = apply_rope(kx, cos, sin)
        mix_x = jnp.concatenate([
            window_attention(qx, kx, vx, kc, vc, attn_sink[l]),
            pool_mixer(poolx, pool_w[l], pool_scale[l]),
            sgu_mixer(ux, zx, sgu_norm_g[l], sgu_w[l], sgu_b[l]),
        ], axis=-1)
        x = x + mx[2] * (mix_x @ w_out[l])
        x = x + mx[5] * swiglu(modulate(rms_norm(x, norm_ffn_g[l]), mx[3], mx[4]), w_gate_up[l], w_down[l])
        if not last:
            mix_c = jnp.concatenate([
                context_attention(qc, kc, vc, attn_sink[l]),
                pool_mixer(poolc, pool_w[l], pool_scale[l]),
                sgu_mixer(uc, zc, sgu_norm_g[l], sgu_w[l], sgu_b[l]),
            ], axis=-1)
            h_ctx = h_ctx + mc[2] * (mix_c @ w_out[l])
            h_ctx = h_ctx + mc[5] * swiglu(modulate(rms_norm(h_ctx, norm_ffn_g[l]), mc[3], mc[4]),
                                           w_gate_up[l], w_down[l])
    return rms_norm(x, final_norm_g)
```

```cpp
#include <hip/hip_runtime.h>
#include <cstdio>
#include <cstdint>
namespace pg8 {
#define PG8_LAS __attribute__((address_space(3)))
typedef unsigned short bf16_t;
typedef short bf16x8 __attribute__((ext_vector_type(8)));
typedef float f32x4 __attribute__((ext_vector_type(4)));
typedef unsigned u32x4 __attribute__((ext_vector_type(4)));
constexpr int BM = 256, BK = 64, HALF = 128, HTB = HALF * BK * 2  , STAGE_BYTES = 8 * HTB, NXCD = 8, WGM = 8;

__host__ __device__ __forceinline__ int lds_byte(int r, int c) { const int st = (r >> 4) * 2 + (c >> 5), rr = r & 15, cc = c & 31, ob = rr * 64 + cc * 2; return st * 1024 + (ob ^ (((ob >> 9) & 1) << 5)); }
__host__ __device__ __forceinline__ void stage_rc(int b, int& R, int& C) { const int st = b / 1024, sb = b % 1024, swz = sb ^ (((sb >> 9) & 1) << 5); R = (st >> 1) * 16 + swz / 64; C = (st & 1) * 32 + (swz % 64) / 2; }
__host__ __device__ __forceinline__ int perm32(int rho) { const int n = rho >> 4, i = rho & 15; return 8 * (i >> 2) + 4 * n + (i & 3); }

struct Unit { int pm, pn; };
struct Gemm { const bf16_t* A; const bf16_t* Bt; int M, N, K; };

struct StaticOrder {
    int nM, nN, nwg, G, c;
    __host__ __device__ void init(int M, int N, int G_, int c_) { nM = M / BM; nN = N / BM; nwg = nM * nN; G = G_; c = c_; }
    __host__ __device__ bool next(int i, Unit& u) const {
        const long L = (long)i * G + c; if (L >= nwg) return false;
        int wgid = (int)L; { const int q = nwg / NXCD, r = nwg % NXCD, xcd = wgid % NXCD, off = wgid / NXCD; wgid = (xcd < r ? xcd * (q + 1) : r * (q + 1) + (xcd - r) * q) + off; }
        const int nig = WGM * nN, gid = wgid / nig, fm = gid * WGM, gsz = (nM - fm) < WGM ? (nM - fm) : WGM;
        u.pm = fm + ((wgid % nig) % gsz); u.pn = (wgid % nig) / gsz; return true;
    }
    __device__ __forceinline__ void a_ready(const Unit&) const {}
    __device__ __forceinline__ void done(const Unit&) const {}
};

__device__ __forceinline__ unsigned cvt_pk_bf16(float lo, float hi) { unsigned r; asm volatile("v_cvt_pk_bf16_f32 %0, %1, %2" : "=v"(r) : "v"(lo), "v"(hi)); return r; }
typedef float f32x2 __attribute__((ext_vector_type(2)));
__device__ __forceinline__ f32x2 gelu_pk(f32x2 v) {
    const f32x2 av = __builtin_elementwise_abs(v), d = av * 0.2316418882f + 1.0f;
    f32x2 t; t.x = __builtin_amdgcn_rcpf(d.x); t.y = __builtin_amdgcn_rcpf(d.y);
    f32x2 q = t * 0.5307027145f + (-0.7265760135f); q = q * t + 0.7107068705f; q = q * t + (-0.142248368f); q = q * t + 0.127414796f; q = q * t;
    const f32x2 s = (v * v) * (-0.72134752044f);
    f32x2 e; e.x = __builtin_amdgcn_exp2f(s.x); e.y = __builtin_amdgcn_exp2f(s.y);
    const f32x2 m = v * (q * e), r = v - m;
    f32x2 o; o.x = v.x < 0.f ? m.x : r.x; o.y = v.y < 0.f ? m.y : r.y; return o;
}
struct EpiIn {
    static constexpr bool PERM = true, AFTER_DRAIN = false;
    bf16_t* P; const float* rope;
    __device__ __forceinline__ void operator()(const f32x4 (&acc)[2][2][4][2], const Unit& u, int wr, int wc, int fr, int fq) const {
        const int row0 = u.pm * BM + wr * 64 + fr;
        if (u.pn >= 5) {
            const int col0 = u.pn * BM + wc * 32 + 8 * fq;
#pragma unroll
            for (int ai = 0; ai < 2; ++ai)
#pragma unroll
                for (int m = 0; m < 4; ++m) { bf16_t* rowp = P + (size_t)(row0 + ai * HALF + m * 16) * 3072 + col0;
#pragma unroll
                    for (int bj = 0; bj < 2; ++bj) { const f32x4 v0 = acc[ai][bj][m][0], v1 = acc[ai][bj][m][1];
                        u32x4 w; w.x = cvt_pk_bf16(v0[0], v0[1]); w.y = cvt_pk_bf16(v0[2], v0[3]); w.z = cvt_pk_bf16(v1[0], v1[1]); w.w = cvt_pk_bf16(v1[2], v1[3]);
                        *(u32x4*)(rowp + bj * HALF) = w; } }
        } else {
            const int hl = wc >> 1, ax = wc & 1, i0 = 8 * fq, colb = u.pn * BM + hl * 128 + ax * 32 + i0;
            const bool rot = u.pm < 32;
#pragma unroll
            for (int ai = 0; ai < 2; ++ai)
#pragma unroll
                for (int m = 0; m < 4; ++m) { const int r = row0 + ai * HALF + m * 16;
                    f32x4 x1a = acc[ai][0][m][0], x1b = acc[ai][0][m][1], x2a = acc[ai][1][m][0], x2b = acc[ai][1][m][1];
                    if (rot) { const int s = r & 2047, pos = ax ? (s & 63) : (s >> 6); const float* cp = rope + pos * 32 + i0;
                        const f32x4 c0 = *(const f32x4*)cp, c1 = *(const f32x4*)(cp + 4), s0 = *(const f32x4*)(cp + 2048), s1 = *(const f32x4*)(cp + 2052);
                        const f32x4 o1a = x1a * c0 - x2a * s0, o1b = x1b * c1 - x2b * s1, o2a = x2a * c0 + x1a * s0, o2b = x2b * c1 + x1b * s1;
                        x1a = o1a; x1b = o1b; x2a = o2a; x2b = o2b; }
                    bf16_t* rowp = P + (size_t)r * 3072 + colb;
                    u32x4 w; w.x = cvt_pk_bf16(x1a[0], x1a[1]); w.y = cvt_pk_bf16(x1a[2], x1a[3]); w.z = cvt_pk_bf16(x1b[0], x1b[1]); w.w = cvt_pk_bf16(x1b[2], x1b[3]);
                    *(u32x4*)rowp = w;
                    w.x = cvt_pk_bf16(x2a[0], x2a[1]); w.y = cvt_pk_bf16(x2a[2], x2a[3]); w.z = cvt_pk_bf16(x2b[0], x2b[1]); w.w = cvt_pk_bf16(x2b[2], x2b[3]);
                    *(u32x4*)(rowp + 64) = w; }
        }
    }
};
struct EpiRes {
    static constexpr bool PERM = false, AFTER_DRAIN = false;
    const float* base_lat; const float* base_ctx; float* X; const float* modl; int gidx;
    __device__ __forceinline__ void operator()(const f32x4 (&acc)[2][2][4][2], const Unit& u, int wr, int wc, int fr, int fq) const {
        const int row0 = u.pm * BM + wr * 64 + fr, col0 = u.pn * BM + wc * 32 + 4 * fq;
        const bool lat = u.pm < 32; const int bidx = lat ? (u.pm >> 3) : 4;
        const float* gate = modl + bidx * 12288 + gidx * 2048 + col0;
        const float* bp0 = lat ? base_lat + (size_t)row0 * 2048 : base_ctx + (size_t)(row0 - 8192) * 2048;
        f32x4 gv[2][2];
#pragma unroll
        for (int bj = 0; bj < 2; ++bj)
#pragma unroll
            for (int n = 0; n < 2; ++n) gv[bj][n] = *(const f32x4*)(gate + bj * HALF + n * 16);
#pragma unroll
        for (int ai = 0; ai < 2; ++ai)
#pragma unroll
            for (int m = 0; m < 4; ++m) { const size_t ro = (size_t)(ai * HALF + m * 16) * 2048 + col0; const float* bp = bp0 + ro; float* xp = X + (size_t)row0 * 2048 + ro;
#pragma unroll
                for (int bj = 0; bj < 2; ++bj)
#pragma unroll
                    for (int n = 0; n < 2; ++n) { const f32x4 bs = *(const f32x4*)(bp + bj * HALF + n * 16); *(f32x4*)(xp + bj * HALF + n * 16) = bs + gv[bj][n] * acc[ai][bj][m][n]; }
                asm volatile("" ::: "memory"); }
    }
};
struct EpiSwiglu {
    static constexpr bool PERM = true, AFTER_DRAIN = false;
    bf16_t* ACT;
    __device__ __forceinline__ static float sw(float g, float up) { return g * __builtin_amdgcn_rcpf(1.0f + __builtin_amdgcn_exp2f(g * -1.4426950408889634f)) * up; }
    __device__ __forceinline__ void operator()(const f32x4 (&acc)[2][2][4][2], const Unit& u, int wr, int wc, int fr, int fq) const {
        const int row0 = u.pm * BM + wr * 64 + fr, col0 = u.pn * 128 + wc * 32 + 8 * fq;
#pragma unroll
        for (int ai = 0; ai < 2; ++ai)
#pragma unroll
            for (int m = 0; m < 4; ++m) { bf16_t* rowp = ACT + (size_t)(row0 + ai * HALF + m * 16) * 5632 + col0;
                const f32x4 g0 = acc[ai][0][m][0], g1 = acc[ai][0][m][1], u0 = acc[ai][1][m][0], u1 = acc[ai][1][m][1];
                u32x4 w; w.x = cvt_pk_bf16(sw(g0[0], u0[0]), sw(g0[1], u0[1])); w.y = cvt_pk_bf16(sw(g0[2], u0[2]), sw(g0[3], u0[3]));
                w.z = cvt_pk_bf16(sw(g1[0], u1[0]), sw(g1[1], u1[1])); w.w = cvt_pk_bf16(sw(g1[2], u1[2]), sw(g1[3], u1[3]));
                *(u32x4*)rowp = w; }
    }
};
template <class Epi, class Sched, bool ALIGN_EPI = false, bool SP2 = false>
__device__ __forceinline__ void gemm_phase(PG8_LAS unsigned char* lds, const Gemm g, const Sched& S, const Epi& E) {
    int tid_ = threadIdx.x; asm volatile("" : "+v"(tid_));
    const int tid = tid_, wid = __builtin_amdgcn_readfirstlane(tid >> 6), lane = tid & 63, wr = wid >> 2, wc = wid & 3, fr = lane & 15, fq = lane >> 4;
    const int K = g.K, nt = K / BK;
    unsigned voffA[2], voffB[2];
#pragma unroll
    for (int i = 0; i < 2; ++i) { int R, C; stage_rc(tid * 16 + i * 8192, R, C); const int Rb = Epi::PERM ? ((R & ~31) + perm32(R & 31)) : R;
        voffA[i] = (unsigned)(R * K + C) * 2u; voffB[i] = (unsigned)(Rb * K + C) * 2u; }
    const size_t kstep = (size_t)(BK * 2);
    const size_t hstep = (size_t)HALF * K * 2;
    const size_t tstep = 2 * hstep;
    const unsigned ldsw = (unsigned)wid * 1024u;
    const int aoff = lds_byte(wr * 64 + fr, fq * 8), boff = lds_byte(wc * 32 + fr, fq * 8);
#define PG8_SA(b, h) (((b) * 2 + (h)) * HTB)
#define PG8_SB(b, h) ((4 + (b) * 2 + (h)) * HTB)
#define PG8_STAGE(bufoff, gbase, voff) do { _Pragma("unroll") for (int _i = 0; _i < 2; ++_i) \
        __builtin_amdgcn_global_load_lds((const unsigned*)((const char*)(gbase) + (voff)[_i]), (PG8_LAS unsigned*)(lds + (bufoff) + ldsw + _i * 8192), 16, 0, 0); } while (0)
#define PG8_LDA(dst, b, h) do { _Pragma("unroll") for (int m = 0; m < 4; ++m) _Pragma("unroll") for (int k = 0; k < 2; ++k) dst[m][k] = *(const PG8_LAS bf16x8*)(lds + PG8_SA(b, h) + aoff + m * 2048 + k * 1024); } while (0)
#define PG8_LDB(dst, b, h) do { _Pragma("unroll") for (int n = 0; n < 2; ++n) _Pragma("unroll") for (int k = 0; k < 2; ++k) dst[n][k] = *(const PG8_LAS bf16x8*)(lds + PG8_SB(b, h) + boff + n * 2048 + k * 1024); } while (0)
#define PG8_MMA(ai, bj, At, Bt) do { __builtin_amdgcn_s_setprio(1); _Pragma("unroll") for (int m = 0; m < 4; ++m) _Pragma("unroll") for (int n = 0; n < 2; ++n) _Pragma("unroll") for (int k = 0; k < 2; ++k) \
        acc[ai][bj][m][n] = __builtin_amdgcn_mfma_f32_16x16x32_bf16(Bt[n][k], At[m][k], acc[ai][bj][m][n], 0, 0, 0); __builtin_amdgcn_s_setprio(0); } while (0)
#define PG8_WAIT_V(n) asm volatile("s_waitcnt vmcnt(" #n ")" ::: "memory")
#define PG8_WAIT_L(n) asm volatile("s_waitcnt lgkmcnt(" #n ")" ::: "memory")
#define PG8_BAR __builtin_amdgcn_s_barrier()
#define PG8_SCHED __builtin_amdgcn_sched_barrier(0)
    Unit cur, nxt; int ui = 0;
    if (!S.next(0, cur)) return;
    f32x4 acc[2][2][4][2];
#pragma unroll
    for (int a = 0; a < 2; ++a)
#pragma unroll
        for (int b = 0; b < 2; ++b)
#pragma unroll
            for (int m = 0; m < 4; ++m)
#pragma unroll
                for (int n = 0; n < 2; ++n) acc[a][b][m][n] = (f32x4){0.f, 0.f, 0.f, 0.f};
    bf16x8 At[4][2], B0[2][2], B1[2][2];
    const char* cA = (const char*)g.A + (size_t)cur.pm * tstep; const char* cB = (const char*)g.Bt + (size_t)cur.pn * tstep;
    S.a_ready(cur);
    if constexpr (SP2) {
        PG8_STAGE(PG8_SB(0, 0), cB, voffB); PG8_STAGE(PG8_SB(0, 1), cB + hstep, voffB); PG8_STAGE(PG8_SA(0, 0), cA, voffA); PG8_STAGE(PG8_SA(0, 1), cA + hstep, voffA);
        if (wr == 1) PG8_BAR;
        PG8_WAIT_V(2); PG8_BAR;
        PG8_STAGE(PG8_SB(1, 0), cB + kstep, voffB); PG8_STAGE(PG8_SA(1, 0), cA + kstep, voffA); PG8_STAGE(PG8_SB(1, 1), cB + hstep + kstep, voffB);
        PG8_WAIT_V(6); PG8_BAR;
    } else {
        PG8_STAGE(PG8_SB(0, 0), cB, voffB); PG8_STAGE(PG8_SA(0, 0), cA, voffA); PG8_STAGE(PG8_SB(0, 1), cB + hstep, voffB); PG8_STAGE(PG8_SA(0, 1), cA + hstep, voffA);
        if (wr == 1) PG8_BAR;
        PG8_WAIT_V(4); PG8_BAR;
        PG8_STAGE(PG8_SB(1, 0), cB + kstep, voffB); PG8_STAGE(PG8_SA(1, 0), cA + kstep, voffA); PG8_STAGE(PG8_SB(1, 1), cB + hstep + kstep, voffB);
        PG8_WAIT_V(6); PG8_BAR;
    }
    for (;;) {
        const bool has_next = S.next(ui + 1, nxt);
        const char* nA = has_next ? (const char*)g.A + (size_t)nxt.pm * tstep : cA; const char* nB = has_next ? (const char*)g.Bt + (size_t)nxt.pn * tstep : cB;
        for (int t = 0; t < nt; t += 2) {
            const bool last = (t == nt - 2);
            const char* a1 = cA + (size_t)(t + 1) * kstep;
            const char* a2 = last ? nA : cA + (size_t)(t + 2) * kstep; const char* b2 = last ? nB : cB + (size_t)(t + 2) * kstep;
            const char* a3 = a2 + kstep; const char* b3 = b2 + kstep;
            if (last && has_next) S.a_ready(nxt);
            if constexpr (SP2) {
            PG8_LDB(B0, 0, 0); PG8_LDB(B1, 0, 1); PG8_SCHED; PG8_LDA(At, 0, 0); PG8_STAGE(PG8_SA(1, 1), a1 + hstep, voffA);
            PG8_WAIT_V(8); PG8_WAIT_L(0); PG8_BAR; PG8_MMA(0, 0, At, B0); PG8_MMA(0, 1, At, B1); PG8_BAR; PG8_SCHED;
            PG8_LDA(At, 0, 1); PG8_STAGE(PG8_SB(0, 0), b2, voffB); PG8_STAGE(PG8_SB(0, 1), b2 + hstep, voffB); PG8_STAGE(PG8_SA(0, 0), a2, voffA);
            PG8_WAIT_V(8); PG8_WAIT_L(0); PG8_BAR; PG8_MMA(1, 0, At, B0); PG8_MMA(1, 1, At, B1); PG8_BAR; PG8_SCHED;
            PG8_LDB(B0, 1, 0); PG8_LDB(B1, 1, 1); PG8_SCHED; PG8_LDA(At, 1, 0); PG8_STAGE(PG8_SA(0, 1), a2 + hstep, voffA);
            PG8_WAIT_V(8); PG8_WAIT_L(0); PG8_BAR; PG8_MMA(0, 0, At, B0); PG8_MMA(0, 1, At, B1); PG8_BAR; PG8_SCHED;
            PG8_LDA(At, 1, 1); PG8_STAGE(PG8_SB(1, 0), b3, voffB); PG8_STAGE(PG8_SB(1, 1), b3 + hstep, voffB); PG8_STAGE(PG8_SA(1, 0), a3, voffA);
            PG8_WAIT_V(8); PG8_WAIT_L(0); PG8_BAR; PG8_MMA(1, 0, At, B0); PG8_MMA(1, 1, At, B1); PG8_BAR; PG8_SCHED;
            } else {
            PG8_LDB(B0, 0, 0); PG8_SCHED; PG8_LDA(At, 0, 0); PG8_STAGE(PG8_SA(1, 1), a1 + hstep, voffA);
            PG8_WAIT_L(8); PG8_BAR; PG8_WAIT_L(0); PG8_MMA(0, 0, At, B0); PG8_BAR; PG8_SCHED;
            PG8_LDB(B1, 0, 1); PG8_STAGE(PG8_SB(0, 0), b2, voffB);
            PG8_BAR; PG8_WAIT_L(0); PG8_MMA(0, 1, At, B1); PG8_BAR;
            PG8_LDA(At, 0, 1); PG8_STAGE(PG8_SA(0, 0), a2, voffA);
            PG8_BAR; PG8_WAIT_L(0); PG8_MMA(1, 0, At, B0); PG8_BAR; PG8_SCHED;
            PG8_STAGE(PG8_SB(0, 1), b2 + hstep, voffB);
            PG8_WAIT_V(6); PG8_BAR; PG8_MMA(1, 1, At, B1); PG8_BAR;
            PG8_LDB(B0, 1, 0); PG8_SCHED; PG8_LDA(At, 1, 0); PG8_STAGE(PG8_SA(0, 1), a2 + hstep, voffA);
            PG8_WAIT_L(8); PG8_BAR; PG8_WAIT_L(0); PG8_MMA(0, 0, At, B0); PG8_BAR; PG8_SCHED;
            PG8_LDB(B1, 1, 1); PG8_STAGE(PG8_SB(1, 0), b3, voffB);
            PG8_BAR; PG8_WAIT_L(0); PG8_MMA(0, 1, At, B1); PG8_BAR;
            PG8_LDA(At, 1, 1); PG8_STAGE(PG8_SA(1, 0), a3, voffA);
            PG8_BAR; PG8_WAIT_L(0); PG8_MMA(1, 0, At, B0); PG8_BAR; PG8_SCHED;
            PG8_STAGE(PG8_SB(1, 1), b3 + hstep, voffB);
            PG8_WAIT_V(6); PG8_BAR; PG8_MMA(1, 1, At, B1); PG8_BAR;
            }
        }
        if constexpr (ALIGN_EPI) { if (wr == 0) PG8_BAR; }
        if constexpr (!Epi::AFTER_DRAIN) { E(acc, cur, wr, wc, fr, fq); S.done(cur); }
        if (!has_next) break;
#pragma unroll
        for (int a = 0; a < 2; ++a)
#pragma unroll
            for (int b = 0; b < 2; ++b)
#pragma unroll
                for (int m = 0; m < 4; ++m)
#pragma unroll
                    for (int n = 0; n < 2; ++n) acc[a][b][m][n] = (f32x4){0.f, 0.f, 0.f, 0.f};
        cur = nxt; cA = nA; cB = nB; ++ui;
        if constexpr (ALIGN_EPI) { if (wr == 1) PG8_BAR; }
    }
    PG8_WAIT_V(0);
    if constexpr (!ALIGN_EPI) { if (wr == 0) PG8_BAR; }
    PG8_BAR;
    if constexpr (Epi::AFTER_DRAIN) { E.fused(acc, cur, wr, wc, fr, fq, lds, wid, lane); S.done(cur); }
#undef PG8_SA
#undef PG8_SB
#undef PG8_STAGE
#undef PG8_LDA
#undef PG8_LDB
#undef PG8_MMA
#undef PG8_WAIT_V
#undef PG8_WAIT_L
#undef PG8_BAR
#undef PG8_SCHED
}
}
namespace att {
using bf16x8 = __attribute__((ext_vector_type(8))) short;
using s16x4  = __attribute__((ext_vector_type(4))) short;
using f32x16 = __attribute__((ext_vector_type(16))) float;
using u32x4  = __attribute__((ext_vector_type(4))) unsigned;
typedef unsigned short bf16;
constexpr int D = 128, NW = 8, QBLK = 32, KVBLK = 64, LDP = 3072;
constexpr float SCALE = 0.088388347648318440f;
constexpr float THR = 8.f;
constexpr size_t SHM_V = KVBLK * D * 2, SHM_K = KVBLK * D * 2, SHM_ATTN = 2 * SHM_V + 2 * SHM_K + NW * 64 * 4;
#define KSWZ(row, colB) ((row) * 256 + ((colB) ^ (((row) & 7) << 4)))
#define SBAR() __builtin_amdgcn_sched_barrier(0)
__device__ __forceinline__ int crow(int r, int hi) { return (r & 3) + 8 * (r >> 2) + 4 * hi; }
__device__ __forceinline__ unsigned cvtpk(float lo, float hi) { unsigned r; asm volatile("v_cvt_pk_bf16_f32 %0, %1, %2" : "=v"(r) : "v"(lo), "v"(hi)); return r; }
__device__ __forceinline__ void maskSM(f32x16& p0, f32x16& p1, int lob, int hib) {
#pragma unroll
  for (int r = 0; r < 16; ++r) { const int kk = (r & 3) + 8 * (r >> 2); p0[r] = (kk < lob || kk > hib) ? -1e30f : p0[r]; p1[r] = (kk + 32 < lob || kk + 32 > hib) ? -1e30f : p1[r]; }
}
__device__ __forceinline__ void partialSM(f32x16& p0, f32x16& p1, float& m_reg, float& mn, float& alpha) {
  constexpr float C = SCALE * 1.4426950408889634f;
  float pmax = p0[0];
#pragma unroll
  for (int r = 1; r < 16; ++r) pmax = fmaxf(pmax, p0[r]);
#pragma unroll
  for (int r = 0; r < 16; ++r) pmax = fmaxf(pmax, p1[r]);
  { auto rr = __builtin_amdgcn_permlane32_swap(__float_as_uint(pmax), __float_as_uint(pmax), false, false);
    pmax = fmaxf(__uint_as_float(rr[0]), __uint_as_float(rr[1])); }
  if (__builtin_expect(__all(pmax - m_reg <= THR / SCALE), 1)) { mn = m_reg; alpha = 1.f; }
  else { mn = fmaxf(m_reg, pmax); alpha = __builtin_amdgcn_exp2f((m_reg - mn) * C); m_reg = mn; }
  float mnC = -mn * C;
#pragma unroll
  for (int r = 0; r < 16; ++r) p0[r] = fmaf(p0[r], C, mnC);
#pragma unroll
  for (int r = 0; r < 16; ++r) p1[r] = fmaf(p1[r], C, mnC);
#pragma unroll
  for (int r = 0; r < 16; ++r) p0[r] = __builtin_amdgcn_exp2f(p0[r]);
}
__device__ __forceinline__ void finishSM(f32x16& p0, f32x16& p1, float alpha, float& l_reg, bf16x8& pa0, bf16x8& pa1, bf16x8& pa2, bf16x8& pa3) {
#pragma unroll
  for (int r = 0; r < 16; ++r) p1[r] = __builtin_amdgcn_exp2f(p1[r]);
  float ps = 0;
#pragma unroll
  for (int r = 0; r < 16; ++r) ps += p0[r];
#pragma unroll
  for (int r = 0; r < 16; ++r) ps += p1[r];
  { auto rr = __builtin_amdgcn_permlane32_swap(__float_as_uint(ps), __float_as_uint(ps), false, false);
    ps = __uint_as_float(rr[0]) + __uint_as_float(rr[1]); }
  l_reg = l_reg * alpha + ps;
#define PK4(P, BASE, OUT) do { unsigned a0 = cvtpk(P[BASE + 0], P[BASE + 1]), a1 = cvtpk(P[BASE + 2], P[BASE + 3]);   \
    unsigned b0 = cvtpk(P[BASE + 4], P[BASE + 5]), b1 = cvtpk(P[BASE + 6], P[BASE + 7]);                              \
    auto r0 = __builtin_amdgcn_permlane32_swap(a0, b0, false, false); auto r1 = __builtin_amdgcn_permlane32_swap(a1, b1, false, false); \
    u32x4 w = {r0[0], r1[0], r0[1], r1[1]}; OUT = *reinterpret_cast<bf16x8*>(&w); } while (0)
  PK4(p0, 0, pa0); PK4(p0, 8, pa1); PK4(p1, 0, pa2); PK4(p1, 8, pa3);
#undef PK4
}
__device__ __forceinline__ void qkt(f32x16& p0, f32x16& p1, const char* Ks, const bf16x8* qr, int r32, int hi) {
  p0 = f32x16{}; p1 = f32x16{};
#pragma unroll
  for (int d0 = 0; d0 < 8; ++d0) { int cb = (d0 * 16 + hi * 8) * 2;
    bf16x8 b0 = *reinterpret_cast<const bf16x8*>(Ks + KSWZ(r32, cb));
    bf16x8 b1 = *reinterpret_cast<const bf16x8*>(Ks + KSWZ(32 + r32, cb));
    p0 = __builtin_amdgcn_mfma_f32_32x32x16_bf16(b0, qr[d0], p0, 0, 0, 0);
    p1 = __builtin_amdgcn_mfma_f32_32x32x16_bf16(b1, qr[d0], p1, 0, 0, 0); }
}
__device__ __forceinline__ int v_st(int k, int c) { const int kk = (k & ~0xC) | ((k & 4) << 1) | ((k & 8) >> 1); return ((kk >> 3) * 4 + (c >> 5)) * 512 + ((kk & 7) * 32 + (c & 31)) * 2; }
__device__ __forceinline__ int v_rd_base(int lane) { return ((lane & 3) << 3) | (((lane >> 2) & 3) << 6) | (((lane >> 4) & 1) << 5) | (((lane >> 5) & 1) << 8); }
constexpr int v_rd_off(int d0, int ks, int half) { return d0 * 512 + ks * 4096 + half * 2048; }
template <int OFF> __device__ __forceinline__ s16x4 tr_read(int vb) {
  s16x4 r; asm volatile("ds_read_b64_tr_b16 %0, %1 offset:%2" : "=&v"(r) : "v"(vb), "i"(OFF) : "memory"); return r;
}
template <int D0> __device__ __forceinline__ void pv_one(f32x16& od, int vb, bf16x8 pa0, bf16x8 pa1, bf16x8 pa2, bf16x8 pa3) {
  const s16x4 l0 = tr_read<v_rd_off(D0, 0, 0)>(vb), h0 = tr_read<v_rd_off(D0, 0, 1)>(vb), l1 = tr_read<v_rd_off(D0, 1, 0)>(vb), h1 = tr_read<v_rd_off(D0, 1, 1)>(vb);
  const s16x4 l2 = tr_read<v_rd_off(D0, 2, 0)>(vb), h2 = tr_read<v_rd_off(D0, 2, 1)>(vb), l3 = tr_read<v_rd_off(D0, 3, 0)>(vb), h3 = tr_read<v_rd_off(D0, 3, 1)>(vb);
  asm volatile("s_waitcnt lgkmcnt(0)" ::: "memory"); SBAR();
#define PK(L, H) (bf16x8){L[0], L[1], L[2], L[3], H[0], H[1], H[2], H[3]}
  od = __builtin_amdgcn_mfma_f32_32x32x16_bf16(pa0, PK(l0, h0), od, 0, 0, 0);
  od = __builtin_amdgcn_mfma_f32_32x32x16_bf16(pa1, PK(l1, h1), od, 0, 0, 0);
  od = __builtin_amdgcn_mfma_f32_32x32x16_bf16(pa2, PK(l2, h2), od, 0, 0, 0);
  od = __builtin_amdgcn_mfma_f32_32x32x16_bf16(pa3, PK(l3, h3), od, 0, 0, 0);
#undef PK
}
__device__ __forceinline__ void pv_d0(f32x16* o, int vb, bf16x8 pa0, bf16x8 pa1, bf16x8 pa2, bf16x8 pa3) {
  pv_one<0>(o[0], vb, pa0, pa1, pa2, pa3); pv_one<1>(o[1], vb, pa0, pa1, pa2, pa3); pv_one<2>(o[2], vb, pa0, pa1, pa2, pa3); pv_one<3>(o[3], vb, pa0, pa1, pa2, pa3);
}
__device__ __forceinline__ void attn_unit(const bf16* __restrict__ P, bf16* __restrict__ MIX, int qrow0w, int qh, int hk, int rqw, float sinkv,
                                          int nloc, int jl0, int kloc0, int kctx0, char* lds) {
  int tid_ = threadIdx.x; asm volatile("" : "+v"(tid_));
  const int tid = tid_, wid = tid >> 6, lane = tid & 63, r32 = lane & 31, hi = lane >> 5;
  char* V_lds = lds; char* K_lds = lds + 2 * SHM_V;
  float* ws = (float*)(lds + 2 * SHM_V + 2 * SHM_K) + wid * 64; float* li_l = ws; float* al_l = ws + 32;
  float m_reg = sinkv * (1.0f / SCALE), l_reg = 1.0f; f32x16 o[4] = {}; bf16x8 qr[8];
  const bf16* Qw = P + (size_t)(qrow0w + r32) * LDP + qh * 128 + hi * 8;
#pragma unroll
  for (int d0 = 0; d0 < 8; ++d0) qr[d0] = *reinterpret_cast<const bf16x8*>(Qw + d0 * 16);
  const int sr = tid >> 4, sc = (tid & 15) * 8, vst0 = v_st(sr, sc), vst1 = v_st(32 + sr, sc);
  const int vb0 = (int)(uintptr_t)V_lds + v_rd_base(lane);
  const int rq = rqw + r32, NT = nloc + 4;
  const unsigned loff = (unsigned)(sr * LDP + sc) * 2u;
  const char* KVb = (const char*)P + (size_t)(1024 + hk * 128) * 2;
  struct { bf16x8 vs0, vs1, ks0, ks1; } sr_[2];
#define TROW(t) ((t) < nloc ? kloc0 + 64 * (t) : kctx0 + 64 * ((t) - nloc))
#define SLOAD(i, t) do { const char* b0_ = KVb + (size_t)TROW(t) * (LDP * 2); const char* b1_ = b0_ + 32 * LDP * 2; \
    sr_[i].vs0 = *reinterpret_cast<const bf16x8*>(b0_ + 512 + loff); sr_[i].vs1 = *reinterpret_cast<const bf16x8*>(b1_ + 512 + loff); \
    sr_[i].ks0 = *reinterpret_cast<const bf16x8*>(b0_ + loff); sr_[i].ks1 = *reinterpret_cast<const bf16x8*>(b1_ + loff); } while (0)
#define SWRITE(b, i) do { *(bf16x8*)(V_lds + (b) * SHM_V + vst0) = sr_[i].vs0; *(bf16x8*)(V_lds + (b) * SHM_V + vst1) = sr_[i].vs1; int kc = sc * 2; \
    *(bf16x8*)(K_lds + (b) * SHM_K + KSWZ(sr, kc)) = sr_[i].ks0; *(bf16x8*)(K_lds + (b) * SHM_K + KSWZ(32 + sr, kc)) = sr_[i].ks1; } while (0)
#define SWAIT() asm volatile("s_waitcnt vmcnt(4)" ::: "memory")
#define RESC(a) do { if (__any((a) < 1.f)) { if (hi == 0) al_l[r32] = (a); asm volatile("s_waitcnt lgkmcnt(0)" ::: "memory"); \
    _Pragma("unroll") for (int d = 0; d < 4; ++d) _Pragma("unroll") for (int r = 0; r < 16; ++r) o[d][r] *= al_l[crow(r, hi)]; } } while (0)
#define MASK(pa, pb, t) do { if ((t) < nloc) { const int jl_ = jl0 + (t); if (jl_ < 2 || jl_ > 3) { \
    const int lob_ = (jl_ == 0 ? rq : (jl_ == 1 ? rq - 64 : -1)) - 4 * hi, hib_ = (jl_ == 4 ? rq : (jl_ == 5 ? rq - 64 : 64)) - 4 * hi; maskSM(pa, pb, lob_, hib_); } } } while (0)
  f32x16 pA0, pA1, pB0, pB1; float mnA, mnB, alA, alB; bf16x8 pa0, pa1, pa2, pa3;
  SLOAD(0, 0); asm volatile("s_waitcnt vmcnt(0)" ::: "memory"); SWRITE(0, 0); __syncthreads();
  qkt(pA0, pA1, K_lds, qr, r32, hi); MASK(pA0, pA1, 0); partialSM(pA0, pA1, m_reg, mnA, alA);
  SLOAD(1, 1); if (2 < NT) SLOAD(0, 2);
  SWAIT(); SWRITE(1, 1); __syncthreads();
  for (int j = 1; j + 1 < NT; j += 2) {
    SBAR(); qkt(pB0, pB1, K_lds + SHM_K, qr, r32, hi); MASK(pB0, pB1, j);
    finishSM(pA0, pA1, alA, l_reg, pa0, pa1, pa2, pa3); SBAR();
    SLOAD(1, j + 2); SBAR();
    pv_d0(o, vb0, pa0, pa1, pa2, pa3); partialSM(pB0, pB1, m_reg, mnB, alB);
    __syncthreads(); SWAIT(); SWRITE(0, 0);
    RESC(alB); __syncthreads();
    SBAR(); qkt(pA0, pA1, K_lds, qr, r32, hi); MASK(pA0, pA1, j + 1);
    finishSM(pB0, pB1, alB, l_reg, pa0, pa1, pa2, pa3); SBAR();
    if (j + 3 < NT) SLOAD(0, j + 3); SBAR();
    pv_d0(o, vb0 + (int)SHM_V, pa0, pa1, pa2, pa3); partialSM(pA0, pA1, m_reg, mnA, alA);
    __syncthreads(); SWAIT(); SWRITE(1, 1);
    RESC(alA); __syncthreads();
  }
  SBAR(); qkt(pB0, pB1, K_lds + SHM_K, qr, r32, hi); MASK(pB0, pB1, NT - 1);
  finishSM(pA0, pA1, alA, l_reg, pa0, pa1, pa2, pa3); SBAR();
  pv_d0(o, vb0, pa0, pa1, pa2, pa3); partialSM(pB0, pB1, m_reg, mnB, alB);
  __syncthreads(); RESC(alB);
  finishSM(pB0, pB1, alB, l_reg, pa0, pa1, pa2, pa3); SBAR();
  pv_d0(o, vb0 + (int)SHM_V, pa0, pa1, pa2, pa3);
  if (hi == 0) li_l[r32] = l_reg; asm volatile("s_waitcnt lgkmcnt(0)" ::: "memory");
  float rli[16];
#pragma unroll
  for (int r = 0; r < 16; ++r) rli[r] = __builtin_amdgcn_rcpf(li_l[crow(r, hi)]);
  bf16* Ow = MIX + (size_t)qrow0w * 2048 + qh * 128 + r32;
#pragma unroll
  for (int r = 0; r < 16; ++r) { const int orow = crow(r, hi);
#pragma unroll
    for (int d0 = 0; d0 < 4; ++d0) { const float v = o[d0][r] * rli[r]; unsigned u = __float_as_uint(v); u = (u + 0x7fffu + ((u >> 16) & 1u)) >> 16; Ow[(size_t)orow * 2048 + d0 * 32] = (bf16)u; } }
  __syncthreads();
#undef TROW
#undef SLOAD
#undef SWRITE
#undef SWAIT
#undef RESC
#undef MASK
}
#undef KSWZ
#undef SBAR
}
constexpr int DM = 2048, NB = 4, SEQ = 2048, DEPTH = 4, CTXL = 256, INW = 3072, DFF = 5632;
constexpr int ML = NB * SEQ, MC = NB * CTXL, MT = ML + MC;
constexpr int C_Q = 0, C_K = 1024, C_V = 1280, C_POOL = 1536, C_U = 2048, C_Z = 2560;
constexpr float EPS = 1e-6f;
constexpr int NWAVES = 8;
constexpr size_t MiB = 1u << 20;
constexpr size_t WS_CTL = 0, CTL_ZERO_BYTES = 2 * MiB;
constexpr size_t WS_MOD = 1 * MiB;
constexpr size_t WS_ROPE = 2 * MiB;
constexpr size_t WS_POOLW = 2 * MiB + 65536;
constexpr size_t WS_SGUW = WS_POOLW + 524288;
constexpr size_t WS_WIN = 4 * MiB;
constexpr size_t WS_WOUT = WS_WIN + (size_t)DEPTH * INW * DM * 2;
constexpr size_t WS_WGU = WS_WOUT + (size_t)DEPTH * DM * DM * 2;
constexpr size_t WS_WDN = WS_WGU + (size_t)DEPTH * 2 * DFF * DM * 2;
constexpr size_t WS_X = WS_WDN + (size_t)DEPTH * DM * DFF * 2;
constexpr size_t WS_A = WS_X + (size_t)MT * DM * 4;
constexpr size_t WS_P = WS_A + (size_t)MT * DM * 2;
constexpr size_t WS_MIX = WS_P + (size_t)MT * INW * 2;
constexpr size_t WS_ACT = WS_MIX + (size_t)MT * DM * 2;
constexpr size_t WS_END = WS_ACT + (size_t)MT * DFF * 2;
constexpr int CW_BAR = 4096;
constexpr int RING_OFF = 0, RING_BYTES = 131072;
constexpr int LDSCTL_OFF = RING_BYTES, MISC_OFF = LDSCTL_OFF + 320;
constexpr int LDS_BYTES = 147456;

#define GAS __attribute__((address_space(1)))
#define LAS __attribute__((address_space(3)))
typedef unsigned short bf16;
typedef unsigned v4u __attribute__((ext_vector_type(4)));
typedef float f32x4 __attribute__((ext_vector_type(4)));
typedef short bf16x8 __attribute__((ext_vector_type(8)));
typedef GAS unsigned gu32;
typedef GAS unsigned long long gu64;
#define RLX_AGENT __ATOMIC_RELAXED, __HIP_MEMORY_SCOPE_AGENT
#define LDS_WAIT() asm volatile("s_waitcnt lgkmcnt(0)" ::: "memory")
#define VM_WAIT() asm volatile("s_waitcnt vmcnt(0)" ::: "memory")
__device__ __forceinline__ unsigned long long rt() { return __builtin_amdgcn_s_memrealtime(); }
__device__ __forceinline__ unsigned f2bf(float f) { unsigned u = __builtin_bit_cast(unsigned, f); return (u + 0x7fffu + ((u >> 16) & 1u)) >> 16; }
__device__ __forceinline__ unsigned pk2(float lo, float hi) { return f2bf(lo) | (f2bf(hi) << 16); }

#define XB_TMO      128
#define XB_XCNT(j)  (256  + 64 * (j))
#define XB_XSUB(j)  (1280 + 64 * (j))
#define XB_XGEN(j)  (2304 + 64 * (j))
#define XB_TOP      3328
#define XB_TOPGEN   3392
#define XCD_BAR_WORDS 3456
#define XB_SPIN_CAP (1u << 18)

__device__ __forceinline__ unsigned xb_ld(unsigned* p)              { return __hip_atomic_load(p, __ATOMIC_RELAXED, __HIP_MEMORY_SCOPE_AGENT); }
__device__ __forceinline__ unsigned xb_add(unsigned* p, unsigned v) { return __hip_atomic_fetch_add(p, v, __ATOMIC_RELAXED, __HIP_MEMORY_SCOPE_AGENT); }
__device__ __forceinline__ unsigned xb_xcc_id() { return (unsigned)__builtin_amdgcn_s_getreg((3 << 11) | 20) & 0xFu; }
#define XB_SPIN(cond, bar) do { unsigned _sp = 0; while (cond) { __builtin_amdgcn_s_sleep(1); \
    if ((++_sp & 255u) == 0u) { if (xb_ld(&(bar)[XB_TMO])) break; if (_sp > XB_SPIN_CAP) { atomicAdd(&(bar)[XB_TMO], 1u); break; } } } } while (0)

struct XcdBarrier {
    unsigned* bar; unsigned x;
    volatile LAS unsigned* st;
};

__device__ __forceinline__ XcdBarrier xcd_barrier_post(unsigned* bar, volatile LAS unsigned* st) {
    XcdBarrier b; b.bar = bar; b.x = xb_xcc_id(); b.st = st;
    if (threadIdx.x == 0) (void)xb_add(&bar[XB_XCNT(b.x)], 1u);
    return b;
}
__device__ __forceinline__ void xcd_barrier_complete(unsigned* bar, unsigned x, unsigned& nloc, unsigned& nx) {
    const unsigned G = gridDim.x * gridDim.y * gridDim.z;
    unsigned sum, cnt, mine, sp = 0u;
    for (;;) {
        sum = 0u; cnt = 0u; mine = 0u;
#pragma unroll
        for (unsigned j = 0; j < 16; ++j) { const unsigned c = xb_ld(&bar[XB_XCNT(j)]); sum += c; cnt += (c > 0u) ? 1u : 0u; mine = (j == x) ? c : mine; }
        if (sum == G) break;
        __builtin_amdgcn_s_sleep(1);
        if ((++sp & 255u) == 0u) { if (xb_ld(&bar[XB_TMO])) break; if (sp > XB_SPIN_CAP) { atomicAdd(&bar[XB_TMO], 1u); break; } }
    }
    nloc = mine > 0u ? mine : 1u; nx = cnt > 0u ? cnt : 1u;
}

__device__ __forceinline__ void xcd_barrier(const XcdBarrier& b) {
    asm volatile("s_waitcnt vmcnt(0)" ::: "memory");
    __syncthreads();
    if (threadIdx.x == 0) {
        unsigned* bar = b.bar;
        __builtin_amdgcn_s_waitcnt(0);
        unsigned nloc = b.st[0], nx = b.st[1];
        if (nloc == 0u) { xcd_barrier_complete(bar, b.x, nloc, nx); b.st[0] = nloc; b.st[1] = nx; }
        const unsigned old = xb_add(&bar[XB_XSUB(b.x)], 1u);
        const unsigned gen = old / nloc;
        if (old + 1u == (gen + 1u) * nloc) {
            __builtin_amdgcn_fence(__ATOMIC_RELEASE, "agent");
            asm volatile("s_waitcnt vmcnt(0)" ::: "memory");
            const unsigned og = xb_add(&bar[XB_TOP], 1u);
            const unsigned tg = og / nx;
            if (og + 1u == (tg + 1u) * nx) xb_add(&bar[XB_TOPGEN], 1u);
            else XB_SPIN(xb_ld(&bar[XB_TOPGEN]) == tg, bar);
            __builtin_amdgcn_fence(__ATOMIC_ACQUIRE, "agent");
            xb_add(&bar[XB_XGEN(b.x)], 1u);
            asm volatile("s_waitcnt vmcnt(0)" ::: "memory");
        } else {
            XB_SPIN(xb_ld(&bar[XB_XGEN(b.x)]) == gen, bar);
            __builtin_amdgcn_fence(__ATOMIC_ACQUIRE, "agent");
            asm volatile("s_waitcnt vmcnt(0)" ::: "memory");
        }
    }
    __syncthreads();
}
struct Params { const float* in[19]; float* out; unsigned char* ws; };
struct Frame { LAS unsigned char* lds; int tid, lane, wave, G, gw, NGW; };
__device__ __forceinline__ Frame mkframe(LAS unsigned char* lds) { Frame F; int t = threadIdx.x; asm volatile("" : "+v"(t)); F.lds = lds; F.tid = t; F.lane = t & 63; F.wave = __builtin_amdgcn_readfirstlane(t >> 6);
    F.G = gridDim.x; F.gw = blockIdx.x * NWAVES + F.wave; F.NGW = F.G * NWAVES; return F; }

__device__ __forceinline__ float wave_sum(float v) {
#pragma unroll
    for (int o = 1; o < 64; o <<= 1) v += __shfl_xor(v, o);
    return v;
}
__device__ __forceinline__ void transpose_item(const float* W, int K, int N, bf16* WT, int k0, int n0, int prow0, LAS float* scr, int lane) {
#pragma unroll 8
    for (int i = 0; i < 32; ++i) { const int kk = 2 * i + (lane >> 5); scr[kk * 33 + (lane & 31)] = W[(size_t)(k0 + kk) * N + n0 + (lane & 31)]; }
    LDS_WAIT(); asm volatile("" ::: "memory");
    const int c = lane & 7;
#pragma unroll
    for (int j = 0; j < 4; ++j) { const int n = (lane >> 3) + 8 * j; const LAS float* s = scr + (8 * c) * 33 + n;
        v4u o; o.x = pk2(s[0 * 33], s[1 * 33]); o.y = pk2(s[2 * 33], s[3 * 33]); o.z = pk2(s[4 * 33], s[5 * 33]); o.w = pk2(s[6 * 33], s[7 * 33]);
        *(GAS v4u*)(WT + (size_t)(prow0 + n) * K + k0 + 8 * c) = o; }
    LDS_WAIT(); asm volatile("" ::: "memory");
}
__device__ __forceinline__ float silu_f(float x) { return x / (1.0f + __expf(-x)); }

template <class PP> __device__ __forceinline__ void prologue(const Frame& F, PP p) {
    unsigned char* ws = p->ws;
    LAS float* scr = (LAS float*)(F.lds + RING_OFF + F.wave * 16384);
    const int lane = F.lane;
    {
        const float* c = p->in[1]; const float* cc = p->in[3]; const float* wada = p->in[4]; const float* bada = p->in[5]; float* mod = (float*)(ws + WS_MOD);
        constexpr int NITA = DEPTH * 32 * 48;
        for (int it = F.gw; it < NITA; it += F.NGW) {
            const int l = it / (32 * 48), r = it % (32 * 48), kc = r / 48, nc = r % 48, k0 = kc * 64, n0 = nc * 256 + 4 * lane;
            float sv[5];
#pragma unroll
            for (int v = 0; v < 4; ++v) sv[v] = silu_f(c[v * DM + k0 + lane]);
            sv[4] = silu_f(cc[k0 + lane]);
            f32x4 acc[5];
#pragma unroll
            for (int v = 0; v < 5; ++v) acc[v] = (f32x4){0.f, 0.f, 0.f, 0.f};
            const float* wp = wada + ((size_t)l * DM + k0) * 12288 + n0;
#pragma unroll 8
            for (int kk = 0; kk < 64; ++kk) { const f32x4 w = *(const f32x4*)(wp + (size_t)kk * 12288);
#pragma unroll
                for (int v = 0; v < 5; ++v) { const float s = __uint_as_float(__builtin_amdgcn_readlane(__float_as_uint(sv[v]), kk)); acc[v] += w * s; } }
            if (kc == 0) { const f32x4 b = *(const f32x4*)(bada + (size_t)l * 12288 + n0);
#pragma unroll
                for (int v = 0; v < 5; ++v) acc[v] += b; }
#pragma unroll
            for (int v = 0; v < 5; ++v) { float* d = mod + ((size_t)l * 5 + v) * 12288 + n0;
#pragma unroll
                for (int j = 0; j < 4; ++j) unsafeAtomicAdd(d + j, acc[v][j]); }
        }
    }
    {
        constexpr int I_IN = (DM / 64) * (INW / 32), I_OUT = (DM / 64) * (DM / 32), I_GU = (DM / 64) * (2 * DFF / 32), I_DN = (DFF / 64) * (DM / 32), I_PW = 16 * 2 * 4;
        constexpr int I_L = I_IN + I_OUT + I_GU + I_DN, NITB = DEPTH * I_L + I_PW;
        for (int it = F.gw; it < NITB; it += F.NGW) {
            if (it >= DEPTH * I_L) {
                const int r = it - DEPTH * I_L, mat = r >> 3, q = r & 7, k0 = (q >> 2) * 64, n0 = (q & 3) * 32;
                transpose_item(p->in[10] + (size_t)mat * 16384, 128, 128, (bf16*)(ws + WS_POOLW) + (size_t)mat * 16384, k0, n0, n0, scr, lane); continue; }
            const int l = it / I_L; int r = it % I_L;
            if (r < I_IN) { const int nblk = INW / 32, k0 = (r / nblk) * 64, n0 = (r % nblk) * 32; int prow = n0;
                if (n0 < C_V) { const int t = n0 >> 8, rem = n0 & 255, hl = rem >> 7, ax = (rem >> 6) & 1, bj = (rem >> 5) & 1; prow = t * 256 + bj * 128 + hl * 64 + ax * 32; }
                transpose_item(p->in[8] + (size_t)l * DM * INW, DM, INW, (bf16*)(ws + WS_WIN) + (size_t)l * INW * DM, k0, n0, prow, scr, lane); continue; } r -= I_IN;
            if (r < I_OUT) { const int nblk = DM / 32, k0 = (r / nblk) * 64, n0 = (r % nblk) * 32;
                transpose_item(p->in[15] + (size_t)l * DM * DM, DM, DM, (bf16*)(ws + WS_WOUT) + (size_t)l * DM * DM, k0, n0, n0, scr, lane); continue; } r -= I_OUT;
            if (r < I_GU) { const int nblk = 2 * DFF / 32, k0 = (r / nblk) * 64, n0 = (r % nblk) * 32; const int bj = n0 >= DFF ? 1 : 0, cidx = n0 - bj * DFF, prow = (cidx >> 7) * 256 + bj * 128 + (cidx & 127);
                transpose_item(p->in[16] + (size_t)l * DM * 2 * DFF, DM, 2 * DFF, (bf16*)(ws + WS_WGU) + (size_t)l * 2 * DFF * DM, k0, n0, prow, scr, lane); continue; } r -= I_GU;
            { const int nblk = DM / 32, k0 = (r / nblk) * 64, n0 = (r % nblk) * 32;
                transpose_item(p->in[17] + (size_t)l * DFF * DM, DFF, DM, (bf16*)(ws + WS_WDN) + (size_t)l * DM * DFF, k0, n0, n0, scr, lane); }
        }
    }
    {
        const int gt = F.gw * 64 + lane, NT = F.NGW * 64;
        const float* sw = p->in[13]; bf16* so = (bf16*)(ws + WS_SGUW);
        for (int i = gt; i < DEPTH * 4 * 128 * 128 / 2; i += NT) ((unsigned*)so)[i] = pk2(sw[2 * i], sw[2 * i + 1]);
        float* rope = (float*)(ws + WS_ROPE);
        for (int i = gt; i < 2048; i += NT) { const int pos = i >> 5, fi = i & 31; const float inv = powf(10000.0f, -(float)(2 * fi) / 64.0f), ang = (float)pos * inv;
            rope[i] = cosf(ang); rope[2048 + i] = sinf(ang); }
    }
}

__device__ __forceinline__ void norm_phase(const Frame& F, const float* xlat, const float* xctx, const float* g, const float* modl, int shift_idx, int scale_idx, bf16* A, int nrows) {
    for (int row = F.gw; row < nrows; row += F.NGW) {
        const bool lat = row < ML; const int bidx = lat ? (row >> 11) : 4;
        const float* src = lat ? xlat + (size_t)row * DM : xctx + (size_t)(row - ML) * DM;
        const GAS f32x4* xr = (const GAS f32x4*)src + F.lane;
        f32x4 v[8]; float ss = 0.f;
#pragma unroll
        for (int j = 0; j < 8; ++j) { v[j] = xr[64 * j]; ss += (v[j].x * v[j].x + v[j].y * v[j].y) + (v[j].z * v[j].z + v[j].w * v[j].w); }
        const float rstd = 1.0f / sqrtf(wave_sum(ss) * (1.0f / DM) + EPS);
        const GAS f32x4* gp = (const GAS f32x4*)g + F.lane;
        const GAS f32x4* shp = (const GAS f32x4*)(modl + bidx * 12288 + shift_idx * DM) + F.lane;
        const GAS f32x4* scp = (const GAS f32x4*)(modl + bidx * 12288 + scale_idx * DM) + F.lane;
        GAS unsigned long long* o8 = (GAS unsigned long long*)(A + (size_t)row * DM) + F.lane;
#pragma unroll
        for (int j = 0; j < 8; ++j) { const f32x4 gg = gp[64 * j], sh = shp[64 * j], sc = scp[64 * j];
            const f32x4 h = (v[j] * rstd * gg) * (sc + 1.0f) + sh;
            o8[64 * j] = (unsigned long long)pk2(h.x, h.y) | ((unsigned long long)pk2(h.z, h.w) << 32); }
    }
}
__device__ __forceinline__ void final_norm(const Frame& F, const float* X, const float* g, float* out) {
    for (int row = F.gw; row < ML; row += F.NGW) {
        const GAS f32x4* xr = (const GAS f32x4*)(X + (size_t)row * DM) + F.lane;
        f32x4 v[8]; float ss = 0.f;
#pragma unroll
        for (int j = 0; j < 8; ++j) { v[j] = xr[64 * j]; ss += (v[j].x * v[j].x + v[j].y * v[j].y) + (v[j].z * v[j].z + v[j].w * v[j].w); }
        const float rstd = 1.0f / sqrtf(wave_sum(ss) * (1.0f / DM) + EPS);
        const GAS f32x4* gp = (const GAS f32x4*)g + F.lane; GAS f32x4* op = (GAS f32x4*)(out + (size_t)row * DM) + F.lane;
#pragma unroll
        for (int j = 0; j < 8; ++j) op[64 * j] = v[j] * rstd * gp[64 * j];
    }
}

constexpr int LP = 136;
__device__ __forceinline__ void mm128(const LAS bf16* As, const LAS bf16* Bs, f32x4 (&acc)[4][2], int w2, int wc, int fr, int fq) {
#pragma unroll
    for (int m = 0; m < 4; ++m)
#pragma unroll
        for (int n = 0; n < 2; ++n) acc[m][n] = (f32x4){0.f, 0.f, 0.f, 0.f};
#pragma unroll
    for (int ks = 0; ks < 4; ++ks) {
        bf16x8 a[4], b[2];
#pragma unroll
        for (int m = 0; m < 4; ++m) a[m] = *(const LAS bf16x8*)(As + (w2 * 64 + m * 16 + fr) * LP + ks * 32 + fq * 8);
#pragma unroll
        for (int n = 0; n < 2; ++n) b[n] = *(const LAS bf16x8*)(Bs + (wc * 32 + n * 16 + fr) * LP + ks * 32 + fq * 8);
#pragma unroll
        for (int m = 0; m < 4; ++m)
#pragma unroll
            for (int n = 0; n < 2; ++n) acc[m][n] = __builtin_amdgcn_mfma_f32_16x16x32_bf16(b[n], a[m], acc[m][n], 0, 0, 0);
    }
}
__device__ __forceinline__ float bf2f(unsigned short h) { return __uint_as_float(((unsigned)h) << 16); }
__device__ __forceinline__ float gelu1(float v) { const pg8::f32x2 r = pg8::gelu_pk((pg8::f32x2){v, v}); return r.x; }
__device__ __forceinline__ void load_tile128(LAS bf16* dst, const bf16* src, int srcld, int tid) {
#pragma unroll
    for (int i = 0; i < 4; ++i) { const int ch = tid + 512 * i, r = ch >> 4, c8 = (ch & 15) * 8; *(LAS v4u*)(dst + r * LP + c8) = *(const GAS v4u*)(src + (size_t)r * srcld + c8); }
}
__device__ __forceinline__ void pool_item(const Frame& F, const bf16* P, bf16* MIX, const bf16* poolwt  , const float* pscale  , int tt, int g) {
    LAS bf16* As = (LAS bf16*)(F.lds); LAS bf16* Bs = As + 128 * LP; LAS bf16* raw = Bs + 128 * LP;
    const int tid = F.tid, row0 = tt * 128; const bool lat = row0 < ML;
    const int S = lat ? SEQ : CTXL, seqbase = lat ? (row0 & ~(SEQ - 1)) : ML + ((row0 - ML) & ~(CTXL - 1)), t0 = row0 - seqbase, half = 1 << g;
    for (int ch = tid; ch < 144 * 16; ch += 512) { const int rr = ch >> 4, c8 = (ch & 15) * 8, t = t0 - 8 + rr;
        v4u v = (v4u){0u, 0u, 0u, 0u}; if (t >= 0 && t < S) v = *(const GAS v4u*)(P + (size_t)(seqbase + t) * INW + C_POOL + g * 128 + c8);
        *(LAS v4u*)(raw + rr * 128 + c8) = v; }
    load_tile128(Bs, poolwt + (size_t)g * 16384, 128, tid);
    LDS_WAIT(); __syncthreads();
    { const int c = tid & 127, rg = tid >> 7; int t = t0 + rg * 32;
      float sum = 0.f; { const int lo = t - half < 0 ? 0 : t - half, hi = t + half > S ? S : t + half; for (int j = lo; j < hi; ++j) sum += bf2f(raw[(j - t0 + 8) * 128 + c]); }
      for (int i = 0; i < 32; ++i, ++t) {
          const int lo = t - half < 0 ? 0 : t - half, hi = t + half > S ? S : t + half;
          const float self = bf2f(raw[(t - t0 + 8) * 128 + c]);
          const float pooled = sum / (float)(hi - lo) - self;
          As[(rg * 32 + i) * LP + c] = (bf16)f2bf(pooled);
          if (t + half < S) sum += bf2f(raw[(t + half - t0 + 8) * 128 + c]);
          if (t - half >= 0) sum -= bf2f(raw[(t - half - t0 + 8) * 128 + c]);
      } }
    LDS_WAIT(); __syncthreads();
    const int w2 = F.wave >> 2, wc = F.wave & 3, fr = F.lane & 15, fq = F.lane >> 4;
    f32x4 acc[4][2]; mm128(As, Bs, acc, w2, wc, fr, fq);
#pragma unroll
    for (int n = 0; n < 2; ++n) { const int d = wc * 32 + n * 16 + 4 * fq; const f32x4 sc = *(const f32x4*)(pscale + g * 128 + d);
#pragma unroll
        for (int m = 0; m < 4; ++m) { const int r = row0 + w2 * 64 + m * 16 + fr; const f32x4 o = acc[m][n] * sc;
            *(GAS unsigned long long*)(MIX + (size_t)r * DM + 1024 + g * 128 + d) = (unsigned long long)pk2(o.x, o.y) | ((unsigned long long)pk2(o.z, o.w) << 32); } }
    __syncthreads();
}
__device__ __forceinline__ void sgu_item(const Frame& F, const bf16* P, bf16* MIX, const bf16* sguw  , const float* normg  , const float* sb  , int tt, int g) {
    LAS bf16* As = (LAS bf16*)(F.lds); LAS bf16* Bs = As + 128 * LP;
    const int tid = F.tid, row0 = tt * 128;
    load_tile128(As, sguw + (size_t)g * 16384, 128, tid);
    { const int q = tid >> 2, part = tid & 3; const bf16* zp = P + (size_t)(row0 + q) * INW + C_Z + g * 128 + part * 32;
      float z[32];
#pragma unroll
      for (int i = 0; i < 4; ++i) { const v4u w = *(const GAS v4u*)(zp + 8 * i);
#pragma unroll
          for (int j = 0; j < 4; ++j) { z[8 * i + 2 * j] = __uint_as_float(w[j] << 16); z[8 * i + 2 * j + 1] = __uint_as_float(w[j] & 0xffff0000u); } }
      float s = 0.f;
#pragma unroll
      for (int i = 0; i < 32; i += 2) { const pg8::f32x2 r = pg8::gelu_pk((pg8::f32x2){z[i], z[i + 1]}); z[i] = r.x; z[i + 1] = r.y; s += r.x + r.y; }
      s += __shfl_xor(s, 1); s += __shfl_xor(s, 2);
      const float mu = s * (1.0f / 128.0f); float q2 = 0.f;
#pragma unroll
      for (int i = 0; i < 32; ++i) { z[i] -= mu; q2 += z[i] * z[i]; }
      q2 += __shfl_xor(q2, 1); q2 += __shfl_xor(q2, 2);
      const float rstd = 1.0f / sqrtf(q2 * (1.0f / 128.0f) + EPS);
      const float* ng = normg + g * 128 + part * 32;
#pragma unroll
      for (int i = 0; i < 32; ++i) Bs[(part * 32 + i) * LP + q] = (bf16)f2bf(z[i] * rstd * ng[i]);
    }
    LDS_WAIT(); __syncthreads();
    const int w2 = F.wave >> 2, wc = F.wave & 3, fr = F.lane & 15, fq = F.lane >> 4;
    f32x4 acc[4][2]; mm128(As, Bs, acc, w2, wc, fr, fq);
#pragma unroll
    for (int m = 0; m < 4; ++m) { const int pr = w2 * 64 + m * 16 + fr, r = row0 + pr; const float bias = sb[g * 128 + pr];
#pragma unroll
        for (int n = 0; n < 2; ++n) { const int c = wc * 32 + n * 16 + 4 * fq;
            const unsigned long long uw = *(const GAS unsigned long long*)(P + (size_t)r * INW + C_U + g * 128 + c);
            const unsigned ulo = (unsigned)uw, uhi = (unsigned)(uw >> 32);
            const pg8::f32x2 ga = pg8::gelu_pk((pg8::f32x2){__uint_as_float(ulo << 16), __uint_as_float(ulo & 0xffff0000u)}), gb = pg8::gelu_pk((pg8::f32x2){__uint_as_float(uhi << 16), __uint_as_float(uhi & 0xffff0000u)});
            const f32x4 mx = acc[m][n] + bias;
            *(GAS unsigned long long*)(MIX + (size_t)r * DM + 1536 + g * 128 + c) = (unsigned long long)pk2(ga.x * mx.x, ga.y * mx.y) | ((unsigned long long)pk2(gb.x * mx.z, gb.y * mx.w) << 32); } }
    __syncthreads();
}

typedef const Params __attribute__((address_space(4))) KParams;
__device__ __forceinline__ KParams* kparams() { KParams* q = (KParams*)__builtin_amdgcn_kernarg_segment_ptr(); asm volatile("" : "+s"(q)); return q; }
__global__ void __launch_bounds__(NWAVES * 64, 2) fwd_kernel(Params p_unused) {
    extern __shared__ __attribute__((aligned(16))) unsigned char lds[];
    for (int u = threadIdx.x; u < (LDS_BYTES - LDSCTL_OFF) / 4; u += NWAVES * 64) ((LAS unsigned*)((LAS unsigned char*)lds + LDSCTL_OFF))[u] = 0u;
    __syncthreads();
    volatile LAS unsigned* MISC = (volatile LAS unsigned*)((LAS unsigned char*)lds + MISC_OFF);
    XcdBarrier bar;
    { KParams* kp = kparams(); const Frame F = mkframe((LAS unsigned char*)lds); bar = xcd_barrier_post((unsigned*)((gu32*)(kp->ws + WS_CTL) + CW_BAR), MISC + 8); }
#define GRID_BAR() xcd_barrier(bar)

    { KParams* kp = kparams(); const Frame F = mkframe((LAS unsigned char*)lds); prologue(F, kp); }
    GRID_BAR();

    for (int l = 0; l < DEPTH; ++l) {
        const bool last = (l == DEPTH - 1);
        const int Mrows = last ? ML : MT;
#ifndef NO_P1
        { KParams* kp = kparams(); const Frame F = mkframe((LAS unsigned char*)lds); unsigned char* ws = kp->ws; const float* X = (const float*)(ws + WS_X);
          norm_phase(F, l == 0 ? kp->in[0] : X, l == 0 ? kp->in[2] : X + (size_t)ML * DM, kp->in[6] + (size_t)l * DM, (const float*)(ws + WS_MOD) + (size_t)l * 5 * 12288, 0, 1, (bf16*)(ws + WS_A), MT); }
#endif
        GRID_BAR();
#ifndef NO_P2
        { KParams* kp = kparams(); const Frame F = mkframe((LAS unsigned char*)lds); unsigned char* ws = kp->ws;
          pg8::Gemm g{(const bf16*)(ws + WS_A), (const bf16*)(ws + WS_WIN) + (size_t)l * INW * DM, MT, INW, DM}; pg8::StaticOrder S; S.init(MT, INW, F.G, (int)blockIdx.x);
          pg8::EpiIn E{(bf16*)(ws + WS_P), (const float*)(ws + WS_ROPE)};
          pg8::gemm_phase<pg8::EpiIn, pg8::StaticOrder, true, true>(F.lds + RING_OFF, g, S, E); }
#endif
        GRID_BAR();
#ifndef NO_P3a
        { KParams* kp = kparams(); const Frame F = mkframe((LAS unsigned char*)lds); unsigned char* ws = kp->ws; const bf16* P = (const bf16*)(ws + WS_P); bf16* MIX = (bf16*)(ws + WS_MIX);
          const float* sink = kp->in[9] + l * 8; const int natt = last ? 256 : 288;
          for (int it = blockIdx.x; it < natt; it += F.G) {
              int qrow0w, qh, hk, rqw, nloc, jl0, kloc0, kctx0;
              if (it < 256) {
                  const int b = it >> 6, rem = it & 63, nq = rem >> 2, pair = rem & 1; hk = (rem >> 1) & 1;
                  qh = hk * 4 + pair * 2 + (F.wave >> 2); rqw = (F.wave & 3) * 32; jl0 = nq == 0 ? 2 : 0; nloc = (nq == 15 ? 3 : 5) - jl0 + 1;
                  qrow0w = b * SEQ + nq * 128 + rqw; kloc0 = b * SEQ + (nq - 1) * 128 + 64 * jl0; kctx0 = ML + b * CTXL;
              } else {
                  const int u = it - 256, b = u >> 3; qh = u & 7; hk = qh >> 2; rqw = 0; nloc = 0; jl0 = 2; kloc0 = 0; kctx0 = ML + b * CTXL; qrow0w = kctx0 + F.wave * 32;
              }
              att::attn_unit(P, MIX, qrow0w, qh, hk, rqw, sink[qh], nloc, jl0, kloc0, kctx0, (char*)lds + RING_OFF);
          } }
#endif
#ifndef NO_P3b
        { KParams* kp = kparams(); const Frame F = mkframe((LAS unsigned char*)lds); unsigned char* ws = kp->ws; const bf16* P = (const bf16*)(ws + WS_P); bf16* MIX = (bf16*)(ws + WS_MIX);
          const int nsmall = (last ? 64 : 72) * 8;
          const bf16* poolwt = (const bf16*)(ws + WS_POOLW) + (size_t)l * 4 * 16384; const bf16* sguw = (const bf16*)(ws + WS_SGUW) + (size_t)l * 4 * 16384;
          for (int s = (int)((blockIdx.x + F.G - 32) % F.G); s < nsmall; s += F.G) {
              const int tt = s >> 3, k = s & 7;
              if (k < 4) pool_item(F, P, MIX, poolwt, kp->in[11] + l * 512, tt, k);
              else sgu_item(F, P, MIX, sguw, kp->in[12] + l * 512, kp->in[14] + l * 512, tt, k - 4);
          } }
#endif
        GRID_BAR();
#ifndef NO_P4
        { KParams* kp = kparams(); const Frame F = mkframe((LAS unsigned char*)lds); unsigned char* ws = kp->ws; float* X = (float*)(ws + WS_X);
          pg8::Gemm g{(const bf16*)(ws + WS_MIX), (const bf16*)(ws + WS_WOUT) + (size_t)l * DM * DM, Mrows, DM, DM}; pg8::StaticOrder S; S.init(Mrows, DM, F.G, (int)blockIdx.x);
          pg8::EpiRes E{l == 0 ? kp->in[0] : X, l == 0 ? kp->in[2] : X + (size_t)ML * DM, X, (const float*)(ws + WS_MOD) + (size_t)l * 5 * 12288, 2};
          pg8::gemm_phase<pg8::EpiRes, pg8::StaticOrder, true, true>(F.lds + RING_OFF, g, S, E); }
#endif
        GRID_BAR();
#ifndef NO_P5
        { KParams* kp = kparams(); const Frame F = mkframe((LAS unsigned char*)lds); unsigned char* ws = kp->ws; const float* X = (const float*)(ws + WS_X);
          norm_phase(F, X, X + (size_t)ML * DM, kp->in[7] + (size_t)l * DM, (const float*)(ws + WS_MOD) + (size_t)l * 5 * 12288, 3, 4, (bf16*)(ws + WS_A), Mrows); }
#endif
        GRID_BAR();
#ifndef NO_P6
        { KParams* kp = kparams(); const Frame F = mkframe((LAS unsigned char*)lds); unsigned char* ws = kp->ws;
          pg8::Gemm g{(const bf16*)(ws + WS_A), (const bf16*)(ws + WS_WGU) + (size_t)l * 2 * DFF * DM, Mrows, 2 * DFF, DM}; pg8::StaticOrder S; S.init(Mrows, 2 * DFF, F.G, (int)blockIdx.x);
          pg8::EpiSwiglu E{(bf16*)(ws + WS_ACT)};
          pg8::gemm_phase<pg8::EpiSwiglu, pg8::StaticOrder, true, true>(F.lds + RING_OFF, g, S, E); }
#endif
        GRID_BAR();
#ifndef NO_P7
        { KParams* kp = kparams(); const Frame F = mkframe((LAS unsigned char*)lds); unsigned char* ws = kp->ws; float* X = (float*)(ws + WS_X);
          pg8::Gemm g{(const bf16*)(ws + WS_ACT), (const bf16*)(ws + WS_WDN) + (size_t)l * DM * DFF, Mrows, DM, DFF}; pg8::StaticOrder S; S.init(Mrows, DM, F.G, (int)blockIdx.x);
          pg8::EpiRes E{X, X + (size_t)ML * DM, X, (const float*)(ws + WS_MOD) + (size_t)l * 5 * 12288, 5};
          pg8::gemm_phase<pg8::EpiRes, pg8::StaticOrder, true, true>(F.lds + RING_OFF, g, S, E); }
#endif
        GRID_BAR();
    }
    { KParams* kp = kparams(); const Frame F = mkframe((LAS unsigned char*)lds); final_norm(F, (const float*)(kp->ws + WS_X), kp->in[18], kp->out); }
}

extern "C" void kernel_launch(void* const* d_in, const int* in_sizes, int n_in, void* d_out, int out_size, void* d_ws, size_t ws_size, hipStream_t stream) {
    static int grid = 0;
    if (grid == 0) {
        if (n_in != 19 || out_size != ML * DM || ws_size < WS_END) { fprintf(stderr, "kernel_launch: unexpected shapes (n_in %d out %d ws %zu, need ws >= %zu)\n", n_in, out_size, ws_size, (size_t)WS_END); grid = -1; return; }
        int dev = 0, cus = 0, per_cu = 0;
        if (hipGetDevice(&dev) != hipSuccess || hipDeviceGetAttribute(&cus, hipDeviceAttributeMultiprocessorCount, dev) != hipSuccess) { grid = -1; return; }
        if (hipFuncSetAttribute((const void*)fwd_kernel, hipFuncAttributeMaxDynamicSharedMemorySize, LDS_BYTES) != hipSuccess) { fprintf(stderr, "kernel_launch: hipFuncSetAttribute failed\n"); grid = -1; return; }
        if (hipOccupancyMaxActiveBlocksPerMultiprocessor(&per_cu, (const void*)fwd_kernel, NWAVES * 64, LDS_BYTES) != hipSuccess || per_cu < 1) { fprintf(stderr, "kernel_launch: occupancy query says %d\n", per_cu); }
        (void)hipGetLastError();
        grid = cus;
    }
    if (grid < 0) return;
    if (hipMemsetAsync((char*)d_ws + WS_CTL, 0, CTL_ZERO_BYTES, stream) != hipSuccess) return;
    Params p{};
    for (int i = 0; i < 19; ++i) p.in[i] = (const float*)d_in[i];
    p.out = (float*)d_out; p.ws = (unsigned char*)d_ws;
    hipLaunchKernelGGL(fwd_kernel, dim3(grid), dim3(NWAVES * 64), LDS_BYTES, stream, p);
}
```

```cpp
#include <hip/hip_runtime.h>
#include <cstdio>
#include <cstdint>
namespace pg8 {
#define PG8_LAS __attribute__((address_space(3)))
typedef unsigned short bf16_t;
typedef short bf16x8 __attribute__((ext_vector_type(8)));
typedef float f32x4 __attribute__((ext_vector_type(4)));
typedef unsigned u32x4 __attribute__((ext_vector_type(4)));
constexpr int BM = 256, BK = 64, HALF = 128, HTB = HALF * BK * 2  , STAGE_BYTES = 8 * HTB, NXCD = 8, WGM = 8;

__host__ __device__ __forceinline__ int lds_byte(int r, int c) { const int st = (r >> 4) * 2 + (c >> 5), rr = r & 15, cc = c & 31, ob = rr * 64 + cc * 2; return st * 1024 + (ob ^ (((ob >> 9) & 1) << 5)); }
__host__ __device__ __forceinline__ void stage_rc(int b, int& R, int& C) { const int st = b / 1024, sb = b % 1024, swz = sb ^ (((sb >> 9) & 1) << 5); R = (st >> 1) * 16 + swz / 64; C = (st & 1) * 32 + (swz % 64) / 2; }
__host__ __device__ __forceinline__ int perm32(int rho) { const int n = rho >> 4, i = rho & 15; return 8 * (i >> 2) + 4 * n + (i & 3); }

struct Unit { int pm, pn, k0b, nt, ks; };
struct Gemm { const bf16_t* A; const bf16_t* Bt; int M, N, K; };

struct StaticOrder {
    int nM, nN, nwg, G, c, ntf;
    __host__ __device__ __forceinline__ void init(int M, int N, int G_, int c_, int K) { nM = M / BM; nN = N / BM; nwg = nM * nN; G = G_; c = c_; ntf = K / BK; }
    __host__ __device__ __forceinline__ void map(int L, int& pm, int& pn) const {
        int wgid = L; { const int q = nwg / NXCD, r = nwg % NXCD, xcd = wgid % NXCD, off = wgid / NXCD; wgid = (xcd < r ? xcd * (q + 1) : r * (q + 1) + (xcd - r) * q) + off; }
        const int nig = WGM * nN, gid = wgid / nig, fm = gid * WGM, gsz = (nM - fm) < WGM ? (nM - fm) : WGM;
        pm = fm + ((wgid % nig) % gsz); pn = (wgid % nig) / gsz;
    }
    __host__ __device__ __forceinline__ bool next(int i, Unit& u) const {
        const int L = i * G + c; const bool ok = L < nwg; int pm = 0, pn = 0; if (ok) map(L, pm, pn);
        u = Unit{pm, pn, 0, ntf, -1}; return ok;
    }
    __device__ __forceinline__ void a_ready(const Unit&) const {}
    __device__ __forceinline__ void done(const Unit&) const {}
};
template <bool DOWN> struct SplitOrder : StaticOrder {
    int nsplit;
    __host__ __device__ __forceinline__ bool next(int i, Unit& u) const {
        const int L = i * G + c, s = L - nwg; const bool whole = L < nwg, ok = whole || s < nsplit;
        int pm = 0, pn = 0, k0b = 0, nt = ntf, ks = -1;
        if (whole) map(L, pm, pn);
        else if (ok) { const int tile = s >> 3; ks = s & 7; pm = 32 + (tile >> 3); pn = tile & 7;
            if (DOWN) { k0b = (ks < 6 ? ks * 768 : 4608 + (ks - 6) * 512) * 2; nt = ks < 6 ? 12 : 8; } else { k0b = ks * 256 * 2; nt = 4; } }
        u = Unit{pm, pn, k0b, nt, ks}; return ok;
    }
};


__device__ __forceinline__ unsigned cvt_pk_bf16(float lo, float hi) { unsigned r; asm volatile("v_cvt_pk_bf16_f32 %0, %1, %2" : "=v"(r) : "v"(lo), "v"(hi)); return r; }
typedef float f32x2 __attribute__((ext_vector_type(2)));
__device__ __forceinline__ f32x2 gelu_pk(f32x2 v) {
    const f32x2 av = __builtin_elementwise_abs(v), d = av * 0.2316418882f + 1.0f;
    f32x2 t; t.x = __builtin_amdgcn_rcpf(d.x); t.y = __builtin_amdgcn_rcpf(d.y);
    f32x2 q = t * 0.5307027145f + (-0.7265760135f); q = q * t + 0.7107068705f; q = q * t + (-0.142248368f); q = q * t + 0.127414796f; q = q * t;
    const f32x2 s = (v * v) * (-0.72134752044f);
    f32x2 e; e.x = __builtin_amdgcn_exp2f(s.x); e.y = __builtin_amdgcn_exp2f(s.y);
    const f32x2 m = v * (q * e), r = v - m;
    f32x2 o; o.x = v.x < 0.f ? m.x : r.x; o.y = v.y < 0.f ? m.y : r.y; return o;
}
struct EpiIn {
    static constexpr bool PERM = true, AFTER_DRAIN = false;
    bf16_t* P; const float* rope;
    __device__ __forceinline__ void operator()(const f32x4 (&acc)[2][2][4][2], const Unit& u, int wr, int wc, int fr, int fq) const {
        const int row0 = u.pm * BM + wr * 64 + fr;
        if (u.pn >= 5) {
            const int col0 = u.pn * BM + wc * 32 + 8 * fq;
#pragma unroll
            for (int ai = 0; ai < 2; ++ai)
#pragma unroll
                for (int m = 0; m < 4; ++m) { bf16_t* rowp = P + (size_t)(row0 + ai * HALF + m * 16) * 3072 + col0;
#pragma unroll
                    for (int bj = 0; bj < 2; ++bj) { const f32x4 v0 = acc[ai][bj][m][0], v1 = acc[ai][bj][m][1];
                        u32x4 w; w.x = cvt_pk_bf16(v0[0], v0[1]); w.y = cvt_pk_bf16(v0[2], v0[3]); w.z = cvt_pk_bf16(v1[0], v1[1]); w.w = cvt_pk_bf16(v1[2], v1[3]);
                        *(u32x4*)(rowp + bj * HALF) = w; } }
        } else {
            const int hl = wc >> 1, ax = wc & 1, i0 = 8 * fq, colb = u.pn * BM + hl * 128 + ax * 32 + i0;
            const bool rot = u.pm < 32;
#pragma unroll
            for (int ai = 0; ai < 2; ++ai)
#pragma unroll
                for (int m = 0; m < 4; ++m) { const int r = row0 + ai * HALF + m * 16;
                    f32x4 x1a = acc[ai][0][m][0], x1b = acc[ai][0][m][1], x2a = acc[ai][1][m][0], x2b = acc[ai][1][m][1];
                    if (rot) { const int s = r & 2047, pos = ax ? (s & 63) : (s >> 6); const float* cp = rope + pos * 32 + i0;
                        const f32x4 c0 = *(const f32x4*)cp, c1 = *(const f32x4*)(cp + 4), s0 = *(const f32x4*)(cp + 2048), s1 = *(const f32x4*)(cp + 2052);
                        const f32x4 o1a = x1a * c0 - x2a * s0, o1b = x1b * c1 - x2b * s1, o2a = x2a * c0 + x1a * s0, o2b = x2b * c1 + x1b * s1;
                        x1a = o1a; x1b = o1b; x2a = o2a; x2b = o2b; }
                    bf16_t* rowp = P + (size_t)r * 3072 + colb;
                    u32x4 w; w.x = cvt_pk_bf16(x1a[0], x1a[1]); w.y = cvt_pk_bf16(x1a[2], x1a[3]); w.z = cvt_pk_bf16(x1b[0], x1b[1]); w.w = cvt_pk_bf16(x1b[2], x1b[3]);
                    *(u32x4*)rowp = w;
                    w.x = cvt_pk_bf16(x2a[0], x2a[1]); w.y = cvt_pk_bf16(x2a[2], x2a[3]); w.z = cvt_pk_bf16(x2b[0], x2b[1]); w.w = cvt_pk_bf16(x2b[2], x2b[3]);
                    *(u32x4*)(rowp + 64) = w; }
        }
    }
};
struct EpiRes {
    static constexpr bool PERM = false, AFTER_DRAIN = false;
    const float* base_lat; float* X; float* slab; const float* modl; int gidx;
    __device__ __forceinline__ void operator()(const f32x4 (&acc)[2][2][4][2], const Unit& u, int wr, int wc, int fr, int fq) const {
        const int row0 = u.pm * BM + wr * 64 + fr, col0 = u.pn * BM + wc * 32 + 4 * fq;
        if (u.ks >= 0) {
            float* sp0 = slab + ((size_t)u.ks * 1024 + (row0 - 8192)) * 2048 + col0;
#pragma unroll
            for (int ai = 0; ai < 2; ++ai)
#pragma unroll
                for (int m = 0; m < 4; ++m) { float* sp = sp0 + (size_t)(ai * HALF + m * 16) * 2048;
#pragma unroll
                    for (int bj = 0; bj < 2; ++bj)
#pragma unroll
                        for (int n = 0; n < 2; ++n) *(f32x4*)(sp + bj * HALF + n * 16) = acc[ai][bj][m][n]; }
            return;
        }
        const float* gate = modl + (u.pm >> 3) * 12288 + gidx * 2048 + col0;
        const float* bp0 = base_lat + (size_t)row0 * 2048;
        f32x4 gv[2][2];
#pragma unroll
        for (int bj = 0; bj < 2; ++bj)
#pragma unroll
            for (int n = 0; n < 2; ++n) gv[bj][n] = *(const f32x4*)(gate + bj * HALF + n * 16);
#pragma unroll
        for (int ai = 0; ai < 2; ++ai)
#pragma unroll
            for (int m = 0; m < 4; ++m) { const size_t ro = (size_t)(ai * HALF + m * 16) * 2048 + col0; const float* bp = bp0 + ro; float* xp = X + (size_t)row0 * 2048 + ro;
#pragma unroll
                for (int bj = 0; bj < 2; ++bj)
#pragma unroll
                    for (int n = 0; n < 2; ++n) { const f32x4 bs = *(const f32x4*)(bp + bj * HALF + n * 16); *(f32x4*)(xp + bj * HALF + n * 16) = bs + gv[bj][n] * acc[ai][bj][m][n]; }
                asm volatile("" ::: "memory"); }
    }
};
struct EpiSwiglu {
    static constexpr bool PERM = true, AFTER_DRAIN = false;
    bf16_t* ACT;
    __device__ __forceinline__ static float sw(float g, float up) { return g * __builtin_amdgcn_rcpf(1.0f + __builtin_amdgcn_exp2f(g * -1.4426950408889634f)) * up; }
    __device__ __forceinline__ void operator()(const f32x4 (&acc)[2][2][4][2], const Unit& u, int wr, int wc, int fr, int fq) const {
        const int row0 = u.pm * BM + wr * 64 + fr, col0 = u.pn * 128 + wc * 32 + 8 * fq;
#pragma unroll
        for (int ai = 0; ai < 2; ++ai)
#pragma unroll
            for (int m = 0; m < 4; ++m) { bf16_t* rowp = ACT + (size_t)(row0 + ai * HALF + m * 16) * 5632 + col0;
                const f32x4 g0 = acc[ai][0][m][0], g1 = acc[ai][0][m][1], u0 = acc[ai][1][m][0], u1 = acc[ai][1][m][1];
                u32x4 w; w.x = cvt_pk_bf16(sw(g0[0], u0[0]), sw(g0[1], u0[1])); w.y = cvt_pk_bf16(sw(g0[2], u0[2]), sw(g0[3], u0[3]));
                w.z = cvt_pk_bf16(sw(g1[0], u1[0]), sw(g1[1], u1[1])); w.w = cvt_pk_bf16(sw(g1[2], u1[2]), sw(g1[3], u1[3]));
                *(u32x4*)rowp = w; }
    }
};
template <class Epi, class Sched, bool ALIGN_EPI = false, bool SP2 = false>
__device__ __forceinline__ void gemm_phase(PG8_LAS unsigned char* lds, const Gemm g, const Sched& S, const Epi& E) {
    int tid_ = threadIdx.x; asm volatile("" : "+v"(tid_));
    const int tid = tid_, wid = __builtin_amdgcn_readfirstlane(tid >> 6), lane = tid & 63, wr = wid >> 2, wc = wid & 3, fr = lane & 15, fq = lane >> 4;
    const int K = g.K;
    unsigned voffA[2], voffB[2];
#pragma unroll
    for (int i = 0; i < 2; ++i) { int R, C; stage_rc(tid * 16 + i * 8192, R, C); const int Rb = Epi::PERM ? ((R & ~31) + perm32(R & 31)) : R;
        voffA[i] = (unsigned)(R * K + C) * 2u; voffB[i] = (unsigned)(Rb * K + C) * 2u; }
    const size_t kstep = (size_t)(BK * 2);
    const size_t hstep = (size_t)HALF * K * 2;
    const size_t tstep = 2 * hstep;
    const unsigned ldsw = (unsigned)wid * 1024u;
    const int aoff = lds_byte(wr * 64 + fr, fq * 8), boff = lds_byte(wc * 32 + fr, fq * 8);
#define PG8_SA(b, h) (((b) * 2 + (h)) * HTB)
#define PG8_SB(b, h) ((4 + (b) * 2 + (h)) * HTB)
#define PG8_STAGE(bufoff, gbase, voff) do { _Pragma("unroll") for (int _i = 0; _i < 2; ++_i) \
        __builtin_amdgcn_global_load_lds((const unsigned*)((const char*)(gbase) + (voff)[_i]), (PG8_LAS unsigned*)(lds + (bufoff) + ldsw + _i * 8192), 16, 0, 0); } while (0)
#define PG8_LDA(dst, b, h) do { _Pragma("unroll") for (int m = 0; m < 4; ++m) _Pragma("unroll") for (int k = 0; k < 2; ++k) dst[m][k] = *(const PG8_LAS bf16x8*)(lds + PG8_SA(b, h) + aoff + m * 2048 + k * 1024); } while (0)
#define PG8_LDB(dst, b, h) do { _Pragma("unroll") for (int n = 0; n < 2; ++n) _Pragma("unroll") for (int k = 0; k < 2; ++k) dst[n][k] = *(const PG8_LAS bf16x8*)(lds + PG8_SB(b, h) + boff + n * 2048 + k * 1024); } while (0)
#define PG8_MMA(ai, bj, At, Bt) do { __builtin_amdgcn_s_setprio(1); _Pragma("unroll") for (int m = 0; m < 4; ++m) _Pragma("unroll") for (int n = 0; n < 2; ++n) _Pragma("unroll") for (int k = 0; k < 2; ++k) \
        acc[ai][bj][m][n] = __builtin_amdgcn_mfma_f32_16x16x32_bf16(Bt[n][k], At[m][k], acc[ai][bj][m][n], 0, 0, 0); __builtin_amdgcn_s_setprio(0); } while (0)
#define PG8_WAIT_V(n) asm volatile("s_waitcnt vmcnt(" #n ")" ::: "memory")
#define PG8_WAIT_L(n) asm volatile("s_waitcnt lgkmcnt(" #n ")" ::: "memory")
#define PG8_BAR __builtin_amdgcn_s_barrier()
#define PG8_SCHED __builtin_amdgcn_sched_barrier(0)
    Unit cur, nxt; int ui = 0;
    if (!S.next(0, cur)) return;
    f32x4 acc[2][2][4][2];
#pragma unroll
    for (int a = 0; a < 2; ++a)
#pragma unroll
        for (int b = 0; b < 2; ++b)
#pragma unroll
            for (int m = 0; m < 4; ++m)
#pragma unroll
                for (int n = 0; n < 2; ++n) acc[a][b][m][n] = (f32x4){0.f, 0.f, 0.f, 0.f};
    bf16x8 At[4][2], B0[2][2], B1[2][2];
    const char* cA = (const char*)g.A + (size_t)cur.pm * tstep + cur.k0b; const char* cB = (const char*)g.Bt + (size_t)cur.pn * tstep + cur.k0b;
    S.a_ready(cur);
    if constexpr (SP2) {
        PG8_STAGE(PG8_SB(0, 0), cB, voffB); PG8_STAGE(PG8_SB(0, 1), cB + hstep, voffB); PG8_STAGE(PG8_SA(0, 0), cA, voffA); PG8_STAGE(PG8_SA(0, 1), cA + hstep, voffA);
        if (wr == 1) PG8_BAR;
        PG8_WAIT_V(2); PG8_BAR;
        PG8_STAGE(PG8_SB(1, 0), cB + kstep, voffB); PG8_STAGE(PG8_SA(1, 0), cA + kstep, voffA); PG8_STAGE(PG8_SB(1, 1), cB + hstep + kstep, voffB);
        PG8_WAIT_V(6); PG8_BAR;
    } else {
        PG8_STAGE(PG8_SB(0, 0), cB, voffB); PG8_STAGE(PG8_SA(0, 0), cA, voffA); PG8_STAGE(PG8_SB(0, 1), cB + hstep, voffB); PG8_STAGE(PG8_SA(0, 1), cA + hstep, voffA);
        if (wr == 1) PG8_BAR;
        PG8_WAIT_V(4); PG8_BAR;
        PG8_STAGE(PG8_SB(1, 0), cB + kstep, voffB); PG8_STAGE(PG8_SA(1, 0), cA + kstep, voffA); PG8_STAGE(PG8_SB(1, 1), cB + hstep + kstep, voffB);
        PG8_WAIT_V(6); PG8_BAR;
    }
    for (;;) {
        const bool has_next = S.next(ui + 1, nxt);
        const char* nA = has_next ? (const char*)g.A + (size_t)nxt.pm * tstep + nxt.k0b : cA; const char* nB = has_next ? (const char*)g.Bt + (size_t)nxt.pn * tstep + nxt.k0b : cB;
        const int nt = cur.nt;
        for (int t = 0; t < nt; t += 2) {
            const bool last = (t == nt - 2);
            const char* a1 = cA + (size_t)(t + 1) * kstep;
            const char* a2 = last ? nA : cA + (size_t)(t + 2) * kstep; const char* b2 = last ? nB : cB + (size_t)(t + 2) * kstep;
            const char* a3 = a2 + kstep; const char* b3 = b2 + kstep;
            if (last && has_next) S.a_ready(nxt);
            if constexpr (SP2) {
            PG8_LDB(B0, 0, 0); PG8_LDB(B1, 0, 1); PG8_SCHED; PG8_LDA(At, 0, 0); PG8_STAGE(PG8_SA(1, 1), a1 + hstep, voffA);
            PG8_WAIT_V(8); PG8_WAIT_L(0); PG8_BAR; PG8_MMA(0, 0, At, B0); PG8_MMA(0, 1, At, B1); PG8_BAR; PG8_SCHED;
            PG8_LDA(At, 0, 1); PG8_STAGE(PG8_SB(0, 0), b2, voffB); PG8_STAGE(PG8_SB(0, 1), b2 + hstep, voffB); PG8_STAGE(PG8_SA(0, 0), a2, voffA);
            PG8_WAIT_V(8); PG8_WAIT_L(0); PG8_BAR; PG8_MMA(1, 0, At, B0); PG8_MMA(1, 1, At, B1); PG8_BAR; PG8_SCHED;
            PG8_LDB(B0, 1, 0); PG8_LDB(B1, 1, 1); PG8_SCHED; PG8_LDA(At, 1, 0); PG8_STAGE(PG8_SA(0, 1), a2 + hstep, voffA);
            PG8_WAIT_V(8); PG8_WAIT_L(0); PG8_BAR; PG8_MMA(0, 0, At, B0); PG8_MMA(0, 1, At, B1); PG8_BAR; PG8_SCHED;
            PG8_LDA(At, 1, 1); PG8_STAGE(PG8_SB(1, 0), b3, voffB); PG8_STAGE(PG8_SB(1, 1), b3 + hstep, voffB); PG8_STAGE(PG8_SA(1, 0), a3, voffA);
            PG8_WAIT_V(8); PG8_WAIT_L(0); PG8_BAR; PG8_MMA(1, 0, At, B0); PG8_MMA(1, 1, At, B1); PG8_BAR; PG8_SCHED;
            } else {
            PG8_LDB(B0, 0, 0); PG8_SCHED; PG8_LDA(At, 0, 0); PG8_STAGE(PG8_SA(1, 1), a1 + hstep, voffA);
            PG8_WAIT_L(8); PG8_BAR; PG8_WAIT_L(0); PG8_MMA(0, 0, At, B0); PG8_BAR; PG8_SCHED;
            PG8_LDB(B1, 0, 1); PG8_STAGE(PG8_SB(0, 0), b2, voffB);
            PG8_BAR; PG8_WAIT_L(0); PG8_MMA(0, 1, At, B1); PG8_BAR;
            PG8_LDA(At, 0, 1); PG8_STAGE(PG8_SA(0, 0), a2, voffA);
            PG8_BAR; PG8_WAIT_L(0); PG8_MMA(1, 0, At, B0); PG8_BAR; PG8_SCHED;
            PG8_STAGE(PG8_SB(0, 1), b2 + hstep, voffB);
            PG8_WAIT_V(6); PG8_BAR; PG8_MMA(1, 1, At, B1); PG8_BAR;
            PG8_LDB(B0, 1, 0); PG8_SCHED; PG8_LDA(At, 1, 0); PG8_STAGE(PG8_SA(0, 1), a2 + hstep, voffA);
            PG8_WAIT_L(8); PG8_BAR; PG8_WAIT_L(0); PG8_MMA(0, 0, At, B0); PG8_BAR; PG8_SCHED;
            PG8_LDB(B1, 1, 1); PG8_STAGE(PG8_SB(1, 0), b3, voffB);
            PG8_BAR; PG8_WAIT_L(0); PG8_MMA(0, 1, At, B1); PG8_BAR;
            PG8_LDA(At, 1, 1); PG8_STAGE(PG8_SA(1, 0), a3, voffA);
            PG8_BAR; PG8_WAIT_L(0); PG8_MMA(1, 0, At, B0); PG8_BAR; PG8_SCHED;
            PG8_STAGE(PG8_SB(1, 1), b3 + hstep, voffB);
            PG8_WAIT_V(6); PG8_BAR; PG8_MMA(1, 1, At, B1); PG8_BAR;
            }
        }
        if constexpr (ALIGN_EPI) { if (wr == 0) PG8_BAR; }
        if constexpr (!Epi::AFTER_DRAIN) { E(acc, cur, wr, wc, fr, fq); S.done(cur); }
        if (!has_next) break;
#pragma unroll
        for (int a = 0; a < 2; ++a)
#pragma unroll
            for (int b = 0; b < 2; ++b)
#pragma unroll
                for (int m = 0; m < 4; ++m)
#pragma unroll
                    for (int n = 0; n < 2; ++n) acc[a][b][m][n] = (f32x4){0.f, 0.f, 0.f, 0.f};
        cur = nxt; cA = nA; cB = nB; ++ui;
        if constexpr (ALIGN_EPI) { if (wr == 1) PG8_BAR; }
    }
    PG8_WAIT_V(0);
    if constexpr (!ALIGN_EPI) { if (wr == 0) PG8_BAR; }
    PG8_BAR;
    if constexpr (Epi::AFTER_DRAIN) { E.fused(acc, cur, wr, wc, fr, fq, lds, wid, lane); S.done(cur); }
#undef PG8_SA
#undef PG8_SB
#undef PG8_STAGE
#undef PG8_LDA
#undef PG8_LDB
#undef PG8_MMA
#undef PG8_WAIT_V
#undef PG8_WAIT_L
#undef PG8_BAR
#undef PG8_SCHED
}
}
namespace att {
using bf16x8 = __attribute__((ext_vector_type(8))) short;
using s16x4  = __attribute__((ext_vector_type(4))) short;
using f32x16 = __attribute__((ext_vector_type(16))) float;
using u32x4  = __attribute__((ext_vector_type(4))) unsigned;
typedef unsigned short bf16;
constexpr int D = 128, NW = 8, QBLK = 32, KVBLK = 64, LDP = 3072;
constexpr float SCALE = 0.088388347648318440f;
constexpr float THR = 8.f;
constexpr size_t SHM_V = KVBLK * D * 2, SHM_K = KVBLK * D * 2, SHM_ATTN = 2 * SHM_V + 2 * SHM_K + NW * 64 * 4;
#define KSWZ(row, colB) ((row) * 256 + ((colB) ^ (((row) & 7) << 4)))
#define SBAR() __builtin_amdgcn_sched_barrier(0)
__device__ __forceinline__ int crow(int r, int hi) { return (r & 3) + 8 * (r >> 2) + 4 * hi; }
__device__ __forceinline__ unsigned cvtpk(float lo, float hi) { unsigned r; asm volatile("v_cvt_pk_bf16_f32 %0, %1, %2" : "=v"(r) : "v"(lo), "v"(hi)); return r; }
__device__ __forceinline__ void maskSM(f32x16& p0, f32x16& p1, int lob, int hib) {
#pragma unroll
  for (int r = 0; r < 16; ++r) { const int kk = (r & 3) + 8 * (r >> 2); p0[r] = (kk < lob || kk > hib) ? -1e30f : p0[r]; p1[r] = (kk + 32 < lob || kk + 32 > hib) ? -1e30f : p1[r]; }
}
__device__ __forceinline__ void partialSM(f32x16& p0, f32x16& p1, float& m_reg, float& mn, float& alpha) {
  constexpr float C = SCALE * 1.4426950408889634f;
  float pmax = p0[0];
#pragma unroll
  for (int r = 1; r < 16; ++r) pmax = fmaxf(pmax, p0[r]);
#pragma unroll
  for (int r = 0; r < 16; ++r) pmax = fmaxf(pmax, p1[r]);
  { auto rr = __builtin_amdgcn_permlane32_swap(__float_as_uint(pmax), __float_as_uint(pmax), false, false);
    pmax = fmaxf(__uint_as_float(rr[0]), __uint_as_float(rr[1])); }
  if (__builtin_expect(__all(pmax - m_reg <= THR / SCALE), 1)) { mn = m_reg; alpha = 1.f; }
  else { mn = fmaxf(m_reg, pmax); alpha = __builtin_amdgcn_exp2f((m_reg - mn) * C); m_reg = mn; }
  float mnC = -mn * C;
#pragma unroll
  for (int r = 0; r < 16; ++r) p0[r] = fmaf(p0[r], C, mnC);
#pragma unroll
  for (int r = 0; r < 16; ++r) p1[r] = fmaf(p1[r], C, mnC);
#pragma unroll
  for (int r = 0; r < 16; ++r) p0[r] = __builtin_amdgcn_exp2f(p0[r]);
}
__device__ __forceinline__ void finishSM(f32x16& p0, f32x16& p1, float alpha, float& l_reg, bf16x8& pa0, bf16x8& pa1, bf16x8& pa2, bf16x8& pa3) {
#pragma unroll
  for (int r = 0; r < 16; ++r) p1[r] = __builtin_amdgcn_exp2f(p1[r]);
  float ps = 0;
#pragma unroll
  for (int r = 0; r < 16; ++r) ps += p0[r];
#pragma unroll
  for (int r = 0; r < 16; ++r) ps += p1[r];
  { auto rr = __builtin_amdgcn_permlane32_swap(__float_as_uint(ps), __float_as_uint(ps), false, false);
    ps = __uint_as_float(rr[0]) + __uint_as_float(rr[1]); }
  l_reg = l_reg * alpha + ps;
#define PK4(P, BASE, OUT) do { unsigned a0 = cvtpk(P[BASE + 0], P[BASE + 1]), a1 = cvtpk(P[BASE + 2], P[BASE + 3]);   \
    unsigned b0 = cvtpk(P[BASE + 4], P[BASE + 5]), b1 = cvtpk(P[BASE + 6], P[BASE + 7]);                              \
    auto r0 = __builtin_amdgcn_permlane32_swap(a0, b0, false, false); auto r1 = __builtin_amdgcn_permlane32_swap(a1, b1, false, false); \
    u32x4 w = {r0[0], r1[0], r0[1], r1[1]}; OUT = *reinterpret_cast<bf16x8*>(&w); } while (0)
  PK4(p0, 0, pa0); PK4(p0, 8, pa1); PK4(p1, 0, pa2); PK4(p1, 8, pa3);
#undef PK4
}
__device__ __forceinline__ void qkt(f32x16& p0, f32x16& p1, const char* Ks, const bf16x8* qr, int r32, int hi) {
  p0 = f32x16{}; p1 = f32x16{};
#pragma unroll
  for (int d0 = 0; d0 < 8; ++d0) { int cb = (d0 * 16 + hi * 8) * 2;
    bf16x8 b0 = *reinterpret_cast<const bf16x8*>(Ks + KSWZ(r32, cb));
    bf16x8 b1 = *reinterpret_cast<const bf16x8*>(Ks + KSWZ(32 + r32, cb));
    p0 = __builtin_amdgcn_mfma_f32_32x32x16_bf16(b0, qr[d0], p0, 0, 0, 0);
    p1 = __builtin_amdgcn_mfma_f32_32x32x16_bf16(b1, qr[d0], p1, 0, 0, 0); }
}
__device__ __forceinline__ int v_st(int k, int c) { const int kk = (k & ~0xC) | ((k & 4) << 1) | ((k & 8) >> 1); return ((kk >> 3) * 4 + (c >> 5)) * 512 + ((kk & 7) * 32 + (c & 31)) * 2; }
__device__ __forceinline__ int v_rd_base(int lane) { return ((lane & 3) << 3) | (((lane >> 2) & 3) << 6) | (((lane >> 4) & 1) << 5) | (((lane >> 5) & 1) << 8); }
constexpr int v_rd_off(int d0, int ks, int half) { return d0 * 512 + ks * 4096 + half * 2048; }
template <int OFF> __device__ __forceinline__ s16x4 tr_read(int vb) {
  s16x4 r; asm volatile("ds_read_b64_tr_b16 %0, %1 offset:%2" : "=&v"(r) : "v"(vb), "i"(OFF) : "memory"); return r;
}
template <int D0> __device__ __forceinline__ void pv_one(f32x16& od, int vb, bf16x8 pa0, bf16x8 pa1, bf16x8 pa2, bf16x8 pa3) {
  const s16x4 l0 = tr_read<v_rd_off(D0, 0, 0)>(vb), h0 = tr_read<v_rd_off(D0, 0, 1)>(vb), l1 = tr_read<v_rd_off(D0, 1, 0)>(vb), h1 = tr_read<v_rd_off(D0, 1, 1)>(vb);
  const s16x4 l2 = tr_read<v_rd_off(D0, 2, 0)>(vb), h2 = tr_read<v_rd_off(D0, 2, 1)>(vb), l3 = tr_read<v_rd_off(D0, 3, 0)>(vb), h3 = tr_read<v_rd_off(D0, 3, 1)>(vb);
  asm volatile("s_waitcnt lgkmcnt(0)" ::: "memory"); SBAR();
#define PK(L, H) (bf16x8){L[0], L[1], L[2], L[3], H[0], H[1], H[2], H[3]}
  od = __builtin_amdgcn_mfma_f32_32x32x16_bf16(pa0, PK(l0, h0), od, 0, 0, 0);
  od = __builtin_amdgcn_mfma_f32_32x32x16_bf16(pa1, PK(l1, h1), od, 0, 0, 0);
  od = __builtin_amdgcn_mfma_f32_32x32x16_bf16(pa2, PK(l2, h2), od, 0, 0, 0);
  od = __builtin_amdgcn_mfma_f32_32x32x16_bf16(pa3, PK(l3, h3), od, 0, 0, 0);
#undef PK
}
__device__ __forceinline__ void pv_d0(f32x16* o, int vb, bf16x8 pa0, bf16x8 pa1, bf16x8 pa2, bf16x8 pa3) {
  pv_one<0>(o[0], vb, pa0, pa1, pa2, pa3); pv_one<1>(o[1], vb, pa0, pa1, pa2, pa3); pv_one<2>(o[2], vb, pa0, pa1, pa2, pa3); pv_one<3>(o[3], vb, pa0, pa1, pa2, pa3);
}
__device__ __forceinline__ void attn_unit(const bf16* __restrict__ P, bf16* __restrict__ MIX, int qrow0w, int qh, int hk, int rqw, float sinkv,
                                          int nloc, int jl0, int kloc0, int kctx0, char* lds) {
  int tid_ = threadIdx.x; asm volatile("" : "+v"(tid_));
  const int tid = tid_, wid = tid >> 6, lane = tid & 63, r32 = lane & 31, hi = lane >> 5;
  char* V_lds = lds; char* K_lds = lds + 2 * SHM_V;
  float* ws = (float*)(lds + 2 * SHM_V + 2 * SHM_K) + wid * 64; float* li_l = ws; float* al_l = ws + 32;
  float m_reg = sinkv * (1.0f / SCALE), l_reg = 1.0f; f32x16 o[4] = {}; bf16x8 qr[8];
  const bf16* Qw = P + (size_t)(qrow0w + r32) * LDP + qh * 128 + hi * 8;
#pragma unroll
  for (int d0 = 0; d0 < 8; ++d0) qr[d0] = *reinterpret_cast<const bf16x8*>(Qw + d0 * 16);
  const int sr = tid >> 4, sc = (tid & 15) * 8, vst0 = v_st(sr, sc), vst1 = v_st(32 + sr, sc);
  const int vb0 = (int)(uintptr_t)V_lds + v_rd_base(lane);
  const int rq = rqw + r32, NT = nloc + 4;
  const unsigned loff = (unsigned)(sr * LDP + sc) * 2u;
  const char* KVb = (const char*)P + (size_t)(1024 + hk * 128) * 2;
  struct { bf16x8 vs0, vs1, ks0, ks1; } sr_[2];
#define TROW(t) ((t) < nloc ? kloc0 + 64 * (t) : kctx0 + 64 * ((t) - nloc))
#define SLOAD(i, t) do { const char* b0_ = KVb + (size_t)TROW(t) * (LDP * 2); const char* b1_ = b0_ + 32 * LDP * 2; \
    sr_[i].vs0 = *reinterpret_cast<const bf16x8*>(b0_ + 512 + loff); sr_[i].vs1 = *reinterpret_cast<const bf16x8*>(b1_ + 512 + loff); \
    sr_[i].ks0 = *reinterpret_cast<const bf16x8*>(b0_ + loff); sr_[i].ks1 = *reinterpret_cast<const bf16x8*>(b1_ + loff); } while (0)
#define SWRITE(b, i) do { *(bf16x8*)(V_lds + (b) * SHM_V + vst0) = sr_[i].vs0; *(bf16x8*)(V_lds + (b) * SHM_V + vst1) = sr_[i].vs1; int kc = sc * 2; \
    *(bf16x8*)(K_lds + (b) * SHM_K + KSWZ(sr, kc)) = sr_[i].ks0; *(bf16x8*)(K_lds + (b) * SHM_K + KSWZ(32 + sr, kc)) = sr_[i].ks1; } while (0)
#define SWAIT() asm volatile("s_waitcnt vmcnt(4)" ::: "memory")
#define RESC(a) do { if (__any((a) < 1.f)) { if (hi == 0) al_l[r32] = (a); asm volatile("s_waitcnt lgkmcnt(0)" ::: "memory"); \
    _Pragma("unroll") for (int d = 0; d < 4; ++d) _Pragma("unroll") for (int r = 0; r < 16; ++r) o[d][r] *= al_l[crow(r, hi)]; } } while (0)
#define MASK(pa, pb, t) do { if ((t) < nloc) { const int jl_ = jl0 + (t); if (jl_ < 2 || jl_ > 3) { \
    const int lob_ = (jl_ == 0 ? rq : (jl_ == 1 ? rq - 64 : -1)) - 4 * hi, hib_ = (jl_ == 4 ? rq : (jl_ == 5 ? rq - 64 : 64)) - 4 * hi; maskSM(pa, pb, lob_, hib_); } } } while (0)
  f32x16 pA0, pA1, pB0, pB1; float mnA, mnB, alA, alB; bf16x8 pa0, pa1, pa2, pa3;
  SLOAD(0, 0); asm volatile("s_waitcnt vmcnt(0)" ::: "memory"); SWRITE(0, 0); __syncthreads();
  qkt(pA0, pA1, K_lds, qr, r32, hi); MASK(pA0, pA1, 0); partialSM(pA0, pA1, m_reg, mnA, alA);
  SLOAD(1, 1); if (2 < NT) SLOAD(0, 2);
  SWAIT(); SWRITE(1, 1); __syncthreads();
  for (int j = 1; j + 1 < NT; j += 2) {
    SBAR(); qkt(pB0, pB1, K_lds + SHM_K, qr, r32, hi); MASK(pB0, pB1, j);
    finishSM(pA0, pA1, alA, l_reg, pa0, pa1, pa2, pa3); SBAR();
    SLOAD(1, j + 2); SBAR();
    pv_d0(o, vb0, pa0, pa1, pa2, pa3); partialSM(pB0, pB1, m_reg, mnB, alB);
    __syncthreads(); SWAIT(); SWRITE(0, 0);
    RESC(alB); __syncthreads();
    SBAR(); qkt(pA0, pA1, K_lds, qr, r32, hi); MASK(pA0, pA1, j + 1);
    finishSM(pB0, pB1, alB, l_reg, pa0, pa1, pa2, pa3); SBAR();
    if (j + 3 < NT) SLOAD(0, j + 3); SBAR();
    pv_d0(o, vb0 + (int)SHM_V, pa0, pa1, pa2, pa3); partialSM(pA0, pA1, m_reg, mnA, alA);
    __syncthreads(); SWAIT(); SWRITE(1, 1);
    RESC(alA); __syncthreads();
  }
  SBAR(); qkt(pB0, pB1, K_lds + SHM_K, qr, r32, hi); MASK(pB0, pB1, NT - 1);
  finishSM(pA0, pA1, alA, l_reg, pa0, pa1, pa2, pa3); SBAR();
  pv_d0(o, vb0, pa0, pa1, pa2, pa3); partialSM(pB0, pB1, m_reg, mnB, alB);
  __syncthreads(); RESC(alB);
  finishSM(pB0, pB1, alB, l_reg, pa0, pa1, pa2, pa3); SBAR();
  pv_d0(o, vb0 + (int)SHM_V, pa0, pa1, pa2, pa3);
  if (hi == 0) li_l[r32] = l_reg; asm volatile("s_waitcnt lgkmcnt(0)" ::: "memory");
  float rli[16];
#pragma unroll
  for (int r = 0; r < 16; ++r) rli[r] = __builtin_amdgcn_rcpf(li_l[crow(r, hi)]);
  bf16* Ow = MIX + (size_t)qrow0w * 2048 + qh * 128 + r32;
#pragma unroll
  for (int r = 0; r < 16; ++r) { const int orow = crow(r, hi);
#pragma unroll
    for (int d0 = 0; d0 < 4; ++d0) { const float v = o[d0][r] * rli[r]; unsigned u = __float_as_uint(v); u = (u + 0x7fffu + ((u >> 16) & 1u)) >> 16; Ow[(size_t)orow * 2048 + d0 * 32] = (bf16)u; } }
  __syncthreads();
#undef TROW
#undef SLOAD
#undef SWRITE
#undef SWAIT
#undef RESC
#undef MASK
}
#undef KSWZ
#undef SBAR
}
constexpr int DM = 2048, NB = 4, SEQ = 2048, DEPTH = 4, CTXL = 256, INW = 3072, DFF = 5632;
constexpr int ML = NB * SEQ, MC = NB * CTXL, MT = ML + MC;
constexpr int C_Q = 0, C_K = 1024, C_V = 1280, C_POOL = 1536, C_U = 2048, C_Z = 2560;
constexpr float EPS = 1e-6f;
constexpr int NWAVES = 8;
constexpr size_t MiB = 1u << 20;
constexpr size_t WS_CTL = 0, CTL_ZERO_BYTES = 2 * MiB;
constexpr size_t WS_MOD = 1 * MiB;
constexpr size_t WS_ROPE = 2 * MiB;
constexpr size_t WS_POOLW = 2 * MiB + 65536;
constexpr size_t WS_SGUW = WS_POOLW + 524288;
constexpr size_t WS_WIN = 4 * MiB;
constexpr size_t WS_WOUT = WS_WIN + (size_t)DEPTH * INW * DM * 2;
constexpr size_t WS_WGU = WS_WOUT + (size_t)DEPTH * DM * DM * 2;
constexpr size_t WS_WDN = WS_WGU + (size_t)DEPTH * 2 * DFF * DM * 2;
constexpr size_t WS_X = WS_WDN + (size_t)DEPTH * DM * DFF * 2;
constexpr size_t WS_A = WS_X + (size_t)MT * DM * 4;
constexpr size_t WS_P = WS_A + (size_t)MT * DM * 2;
constexpr size_t WS_MIX = WS_P + (size_t)MT * INW * 2;
constexpr size_t WS_ACT = WS_MIX + (size_t)MT * DM * 2;
constexpr size_t WS_SLAB = WS_ACT + (size_t)MT * DFF * 2;
constexpr size_t WS_END = WS_SLAB + (size_t)8 * MC * DM * 4;
constexpr int CW_BAR = 4096;
constexpr int CW_Q = 8192;
constexpr int NCH_P2 = 250;
constexpr int RING_OFF = 0, RING_BYTES = 131072;
constexpr int LDSCTL_OFF = RING_BYTES, MISC_OFF = LDSCTL_OFF + 320;
constexpr int LDS_BYTES = 147456;

#define GAS __attribute__((address_space(1)))
#define LAS __attribute__((address_space(3)))
typedef unsigned short bf16;
typedef unsigned v4u __attribute__((ext_vector_type(4)));
typedef float f32x4 __attribute__((ext_vector_type(4)));
typedef short bf16x8 __attribute__((ext_vector_type(8)));
typedef GAS unsigned gu32;
typedef GAS unsigned long long gu64;
#define RLX_AGENT __ATOMIC_RELAXED, __HIP_MEMORY_SCOPE_AGENT
#define LDS_WAIT() asm volatile("s_waitcnt lgkmcnt(0)" ::: "memory")
#define VM_WAIT() asm volatile("s_waitcnt vmcnt(0)" ::: "memory")
__device__ __forceinline__ unsigned long long rt() { return __builtin_amdgcn_s_memrealtime(); }
__device__ __forceinline__ unsigned f2bf(float f) { unsigned u = __builtin_bit_cast(unsigned, f); return (u + 0x7fffu + ((u >> 16) & 1u)) >> 16; }
__device__ __forceinline__ unsigned pk2(float lo, float hi) { return f2bf(lo) | (f2bf(hi) << 16); }

#define XB_TMO      128
#define XB_XCNT(j)  (256  + 64 * (j))
#define XB_XSUB(j)  (1280 + 64 * (j))
#define XB_XGEN(j)  (2304 + 64 * (j))
#define XB_TOP      3328
#define XB_TOPGEN   3392
#define XCD_BAR_WORDS 3456
#define XB_SPIN_CAP (1u << 18)

__device__ __forceinline__ unsigned xb_ld(unsigned* p)              { return __hip_atomic_load(p, __ATOMIC_RELAXED, __HIP_MEMORY_SCOPE_AGENT); }
__device__ __forceinline__ unsigned xb_add(unsigned* p, unsigned v) { return __hip_atomic_fetch_add(p, v, __ATOMIC_RELAXED, __HIP_MEMORY_SCOPE_AGENT); }
__device__ __forceinline__ unsigned xb_xcc_id() { return (unsigned)__builtin_amdgcn_s_getreg((3 << 11) | 20) & 0xFu; }
#define XB_SPIN(cond, bar) do { unsigned _sp = 0; while (cond) { __builtin_amdgcn_s_sleep(1); \
    if ((++_sp & 255u) == 0u) { if (xb_ld(&(bar)[XB_TMO])) break; if (_sp > XB_SPIN_CAP) { atomicAdd(&(bar)[XB_TMO], 1u); break; } } } } while (0)

struct XcdBarrier {
    unsigned* bar; unsigned x;
    volatile LAS unsigned* st;
};

__device__ __forceinline__ XcdBarrier xcd_barrier_post(unsigned* bar, volatile LAS unsigned* st) {
    XcdBarrier b; b.bar = bar; b.x = xb_xcc_id(); b.st = st;
    if (threadIdx.x == 0) (void)xb_add(&bar[XB_XCNT(b.x)], 1u);
    return b;
}
__device__ __forceinline__ void xcd_barrier_complete(unsigned* bar, unsigned x, unsigned& nloc, unsigned& nx) {
    const unsigned G = gridDim.x * gridDim.y * gridDim.z;
    unsigned sum, cnt, mine, sp = 0u;
    for (;;) {
        sum = 0u; cnt = 0u; mine = 0u;
#pragma unroll
        for (unsigned j = 0; j < 16; ++j) { const unsigned c = xb_ld(&bar[XB_XCNT(j)]); sum += c; cnt += (c > 0u) ? 1u : 0u; mine = (j == x) ? c : mine; }
        if (sum == G) break;
        __builtin_amdgcn_s_sleep(1);
        if ((++sp & 255u) == 0u) { if (xb_ld(&bar[XB_TMO])) break; if (sp > XB_SPIN_CAP) { atomicAdd(&bar[XB_TMO], 1u); break; } }
    }
    nloc = mine > 0u ? mine : 1u; nx = cnt > 0u ? cnt : 1u;
}

__device__ __forceinline__ void xcd_barrier(const XcdBarrier& b) {
    asm volatile("s_waitcnt vmcnt(0)" ::: "memory");
    __syncthreads();
    if (threadIdx.x == 0) {
        unsigned* bar = b.bar;
        __builtin_amdgcn_s_waitcnt(0);
        unsigned nloc = b.st[0], nx = b.st[1];
        if (nloc == 0u) { xcd_barrier_complete(bar, b.x, nloc, nx); b.st[0] = nloc; b.st[1] = nx; }
        const unsigned old = xb_add(&bar[XB_XSUB(b.x)], 1u);
        const unsigned gen = old / nloc;
        if (old + 1u == (gen + 1u) * nloc) {
            __builtin_amdgcn_fence(__ATOMIC_RELEASE, "agent");
            asm volatile("s_waitcnt vmcnt(0)" ::: "memory");
            const unsigned og = xb_add(&bar[XB_TOP], 1u);
            const unsigned tg = og / nx;
            if (og + 1u == (tg + 1u) * nx) xb_add(&bar[XB_TOPGEN], 1u);
            else XB_SPIN(xb_ld(&bar[XB_TOPGEN]) == tg, bar);
            __builtin_amdgcn_fence(__ATOMIC_ACQUIRE, "agent");
            xb_add(&bar[XB_XGEN(b.x)], 1u);
            asm volatile("s_waitcnt vmcnt(0)" ::: "memory");
        } else {
            XB_SPIN(xb_ld(&bar[XB_XGEN(b.x)]) == gen, bar);
            __builtin_amdgcn_fence(__ATOMIC_ACQUIRE, "agent");
            asm volatile("s_waitcnt vmcnt(0)" ::: "memory");
        }
    }
    __syncthreads();
}
#ifndef PRO_LAYERS
#define PRO_LAYERS 1
#endif
struct Params { const float* in[19]; float* out; unsigned char* ws; };
struct Frame { LAS unsigned char* lds; int tid, lane, wave, G, gw, NGW; };
__device__ __forceinline__ Frame mkframe(LAS unsigned char* lds) { Frame F; int t = threadIdx.x; asm volatile("" : "+v"(t)); F.lds = lds; F.tid = t; F.lane = t & 63; F.wave = __builtin_amdgcn_readfirstlane(t >> 6);
    F.G = gridDim.x; F.gw = blockIdx.x * NWAVES + F.wave; F.NGW = F.G * NWAVES; return F; }

__device__ __forceinline__ float wave_sum(float v) {
#pragma unroll
    for (int o = 1; o < 64; o <<= 1) v += __shfl_xor(v, o);
    return v;
}
__device__ __forceinline__ void transpose_item(const float* W, int K, int N, bf16* WT, int k0, int n0, int prow0, LAS float* scr, int lane) {
    const int lk = lane >> 3, ln = (lane & 7) * 4;
    f32x4 v[8];
#pragma unroll
    for (int i = 0; i < 8; ++i) v[i] = __builtin_nontemporal_load((const f32x4*)(W + (size_t)(k0 + 8 * i + lk) * N + n0 + ln));
#pragma unroll
    for (int i = 0; i < 8; ++i) { LAS float* d = scr + (8 * i + lk) * 33 + ln; d[0] = v[i].x; d[1] = v[i].y; d[2] = v[i].z; d[3] = v[i].w; }
    LDS_WAIT(); asm volatile("" ::: "memory");
    const int c = lane & 7;
#pragma unroll
    for (int j = 0; j < 4; ++j) { const int n = (lane >> 3) + 8 * j; const LAS float* s = scr + (8 * c) * 33 + n;
        v4u o; o.x = pk2(s[0 * 33], s[1 * 33]); o.y = pk2(s[2 * 33], s[3 * 33]); o.z = pk2(s[4 * 33], s[5 * 33]); o.w = pk2(s[6 * 33], s[7 * 33]);
        *(GAS v4u*)(WT + (size_t)(prow0 + n) * K + k0 + 8 * c) = o; }
    LDS_WAIT(); asm volatile("" ::: "memory");
}
__device__ __forceinline__ float silu_f(float x) { return x / (1.0f + __expf(-x)); }

constexpr int I_IN = (DM / 64) * (INW / 32), I_OUT = (DM / 64) * (DM / 32), I_GU = (DM / 64) * (2 * DFF / 32), I_DN = (DFF / 64) * (DM / 32), I_L = I_IN + I_OUT + I_GU + I_DN;
constexpr int NCH_A = 192, NCH_T = I_L / 32, NCH = NCH_A + NCH_T;
static_assert(I_L % 32 == 0, "whole chunks");
template <class PP> __device__ __forceinline__ void prep_chunk(const Frame& F, PP p, int l, int ch) {
    unsigned char* ws = p->ws; const int lane = F.lane;
    if (ch < NCH_A) {
        const int nc = ch % 48, kg = ch / 48, k0 = (kg * 8 + F.wave) * 64, n0 = nc * 256 + 4 * lane;
        const float* c = p->in[1]; const float* cc = p->in[3];
        float sv[5];
#pragma unroll
        for (int v = 0; v < 4; ++v) sv[v] = silu_f(c[v * DM + k0 + lane]);
        sv[4] = silu_f(cc[k0 + lane]);
        f32x4 acc[5];
#pragma unroll
        for (int v = 0; v < 5; ++v) acc[v] = (f32x4){0.f, 0.f, 0.f, 0.f};
        const float* wp = p->in[4] + ((size_t)l * DM + k0) * 12288 + n0;
#pragma unroll 8
        for (int kk = 0; kk < 64; ++kk) { const f32x4 w = __builtin_nontemporal_load((const f32x4*)(wp + (size_t)kk * 12288));
#pragma unroll
            for (int v = 0; v < 5; ++v) { const float s = __uint_as_float(__builtin_amdgcn_readlane(__float_as_uint(sv[v]), kk)); acc[v] += w * s; } }
        LAS float* red = (LAS float*)(F.lds + RING_OFF);
#pragma unroll
        for (int v = 0; v < 5; ++v) *(LAS f32x4*)(red + (F.wave * 5 + v) * 256 + 4 * lane) = acc[v];
        LDS_WAIT(); __syncthreads();
        float* mod = (float*)(ws + WS_MOD) + (size_t)l * 5 * 12288; const float* bada = p->in[5] + (size_t)l * 12288;
        for (int o = F.tid; o < 1280; o += 512) { const int v = o >> 8, cidx = o & 255; float s = 0.f;
#pragma unroll
            for (int w = 0; w < 8; ++w) s += red[(w * 5 + v) * 256 + cidx];
            if (kg == 0) s += bada[nc * 256 + cidx];
            unsafeAtomicAdd(mod + v * 12288 + nc * 256 + cidx, s); }
        __syncthreads();
        return;
    }
    LAS float* scr = (LAS float*)(F.lds + RING_OFF + F.wave * 16384);
#pragma unroll 1
    for (int i = 0; i < 4; ++i) {
        int r = (ch - NCH_A) * 32 + i * 8 + F.wave;
        if (r < I_IN) { const int nblk = INW / 32, k0 = (r / nblk) * 64, n0 = (r % nblk) * 32; int prow = n0;
            if (n0 < C_V) { const int t = n0 >> 8, rem = n0 & 255, hl = rem >> 7, ax = (rem >> 6) & 1, bj = (rem >> 5) & 1; prow = t * 256 + bj * 128 + hl * 64 + ax * 32; }
            transpose_item(p->in[8] + (size_t)l * DM * INW, DM, INW, (bf16*)(ws + WS_WIN) + (size_t)l * INW * DM, k0, n0, prow, scr, lane); continue; } r -= I_IN;
        if (r < I_OUT) { const int nblk = DM / 32, k0 = (r / nblk) * 64, n0 = (r % nblk) * 32;
            transpose_item(p->in[15] + (size_t)l * DM * DM, DM, DM, (bf16*)(ws + WS_WOUT) + (size_t)l * DM * DM, k0, n0, n0, scr, lane); continue; } r -= I_OUT;
        if (r < I_GU) { const int nblk = 2 * DFF / 32, k0 = (r / nblk) * 64, n0 = (r % nblk) * 32; const int bj = n0 >= DFF ? 1 : 0, cidx = n0 - bj * DFF, prow = (cidx >> 7) * 256 + bj * 128 + (cidx & 127);
            transpose_item(p->in[16] + (size_t)l * DM * 2 * DFF, DM, 2 * DFF, (bf16*)(ws + WS_WGU) + (size_t)l * 2 * DFF * DM, k0, n0, prow, scr, lane); continue; } r -= I_GU;
        { const int nblk = DM / 32, k0 = (r / nblk) * 64, n0 = (r % nblk) * 32;
            transpose_item(p->in[17] + (size_t)l * DFF * DM, DFF, DM, (bf16*)(ws + WS_WDN) + (size_t)l * DM * DFF, k0, n0, n0, scr, lane); }
    }
}
template <class PP> __device__ __forceinline__ void steal_prep(const Frame& F, PP p, int l, gu32* q, int lo, int hi, volatile LAS unsigned* tick) {
    for (;;) {
        if (F.tid == 0) tick[0] = (unsigned)lo + __hip_atomic_fetch_add(q, 1u, __ATOMIC_RELAXED, __HIP_MEMORY_SCOPE_AGENT);
        LDS_WAIT(); __syncthreads();
        const int ch = (int)tick[0];
        __syncthreads();
        if (ch >= hi) break;
        prep_chunk(F, p, l, ch);
    }
}
template <class PP> __device__ __forceinline__ void prologue(const Frame& F, PP p) {
    unsigned char* ws = p->ws; const int lane = F.lane;
    _Pragma("nounroll") for (int l = 0; l < PRO_LAYERS; ++l)
        for (int ch = blockIdx.x; ch < NCH; ch += F.G) prep_chunk(F, p, l, ch);
    {
        LAS float* scr = (LAS float*)(F.lds + RING_OFF + F.wave * 16384);
        for (int r = F.gw; r < 16 * 8; r += F.NGW) { const int mat = r >> 3, q = r & 7, k0 = (q >> 2) * 64, n0 = (q & 3) * 32;
            transpose_item(p->in[10] + (size_t)mat * 16384, 128, 128, (bf16*)(ws + WS_POOLW) + (size_t)mat * 16384, k0, n0, n0, scr, lane); }
    }
    {
        const int gt = F.gw * 64 + lane, NT = F.NGW * 64;
        const float* sw = p->in[13]; bf16* so = (bf16*)(ws + WS_SGUW);
        for (int i = gt; i < DEPTH * 4 * 128 * 128 / 2; i += NT) ((unsigned*)so)[i] = pk2(sw[2 * i], sw[2 * i + 1]);
        float* rope = (float*)(ws + WS_ROPE);
        for (int i = gt; i < 2048; i += NT) { const int pos = i >> 5, fi = i & 31; const float inv = powf(10000.0f, -(float)(2 * fi) / 64.0f), ang = (float)pos * inv;
            rope[i] = cosf(ang); rope[2048 + i] = sinf(ang); }
    }
}

__device__ __forceinline__ void norm_phase(const Frame& F, const float* xlat, const float* xctx, const float* g, const float* modl, int shift_idx, int scale_idx, bf16* A, int nrows,
                                           const float* slab, const float* rgate, float* xw) {
    for (int row = F.gw; row < nrows; row += F.NGW) {
        const bool lat = row < ML; const int bidx = lat ? (row >> 11) : 4;
        const float* src = lat ? xlat + (size_t)row * DM : xctx + (size_t)(row - ML) * DM;
        const GAS f32x4* xr = (const GAS f32x4*)src + F.lane;
        f32x4 v[8];
#pragma unroll
        for (int j = 0; j < 8; ++j) v[j] = xr[64 * j];
        if (!lat && slab) {
            const GAS f32x4* sp = (const GAS f32x4*)(slab + (size_t)(row - ML) * DM) + F.lane; const GAS f32x4* gp = (const GAS f32x4*)rgate + F.lane;
            GAS f32x4* wp = (GAS f32x4*)(xw + (size_t)(row - ML) * DM) + F.lane;
#pragma unroll
            for (int j = 0; j < 8; ++j) { f32x4 s = sp[64 * j];
#pragma unroll
                for (int k = 1; k < 8; ++k) s += sp[(size_t)k * (MC * DM / 4) + 64 * j];
                v[j] = v[j] + gp[64 * j] * s; wp[64 * j] = v[j]; }
        }
        float ss = 0.f;
#pragma unroll
        for (int j = 0; j < 8; ++j) ss += (v[j].x * v[j].x + v[j].y * v[j].y) + (v[j].z * v[j].z + v[j].w * v[j].w);
        const float rstd = 1.0f / sqrtf(wave_sum(ss) * (1.0f / DM) + EPS);
        const GAS f32x4* gp = (const GAS f32x4*)g + F.lane;
        const GAS f32x4* shp = (const GAS f32x4*)(modl + bidx * 12288 + shift_idx * DM) + F.lane;
        const GAS f32x4* scp = (const GAS f32x4*)(modl + bidx * 12288 + scale_idx * DM) + F.lane;
        GAS unsigned long long* o8 = (GAS unsigned long long*)(A + (size_t)row * DM) + F.lane;
#pragma unroll
        for (int j = 0; j < 8; ++j) { const f32x4 gg = gp[64 * j], sh = shp[64 * j], sc = scp[64 * j];
            const f32x4 h = (v[j] * rstd * gg) * (sc + 1.0f) + sh;
            o8[64 * j] = (unsigned long long)pk2(h.x, h.y) | ((unsigned long long)pk2(h.z, h.w) << 32); }
    }
}
__device__ __forceinline__ void final_norm(const Frame& F, const float* X, const float* g, float* out) {
    for (int row = F.gw; row < ML; row += F.NGW) {
        const GAS f32x4* xr = (const GAS f32x4*)(X + (size_t)row * DM) + F.lane;
        f32x4 v[8]; float ss = 0.f;
#pragma unroll
        for (int j = 0; j < 8; ++j) { v[j] = xr[64 * j]; ss += (v[j].x * v[j].x + v[j].y * v[j].y) + (v[j].z * v[j].z + v[j].w * v[j].w); }
        const float rstd = 1.0f / sqrtf(wave_sum(ss) * (1.0f / DM) + EPS);
        const GAS f32x4* gp = (const GAS f32x4*)g + F.lane; GAS f32x4* op = (GAS f32x4*)(out + (size_t)row * DM) + F.lane;
#pragma unroll
        for (int j = 0; j < 8; ++j) op[64 * j] = v[j] * rstd * gp[64 * j];
    }
}

constexpr int LP = 136;
__device__ __forceinline__ void mm128(const LAS bf16* As, const LAS bf16* Bs, f32x4 (&acc)[4][2], int w2, int wc, int fr, int fq) {
#pragma unroll
    for (int m = 0; m < 4; ++m)
#pragma unroll
        for (int n = 0; n < 2; ++n) acc[m][n] = (f32x4){0.f, 0.f, 0.f, 0.f};
#pragma unroll
    for (int ks = 0; ks < 4; ++ks) {
        bf16x8 a[4], b[2];
#pragma unroll
        for (int m = 0; m < 4; ++m) a[m] = *(const LAS bf16x8*)(As + (w2 * 64 + m * 16 + fr) * LP + ks * 32 + fq * 8);
#pragma unroll
        for (int n = 0; n < 2; ++n) b[n] = *(const LAS bf16x8*)(Bs + (wc * 32 + n * 16 + fr) * LP + ks * 32 + fq * 8);
#pragma unroll
        for (int m = 0; m < 4; ++m)
#pragma unroll
            for (int n = 0; n < 2; ++n) acc[m][n] = __builtin_amdgcn_mfma_f32_16x16x32_bf16(b[n], a[m], acc[m][n], 0, 0, 0);
    }
}
__device__ __forceinline__ float bf2f(unsigned short h) { return __uint_as_float(((unsigned)h) << 16); }
__device__ __forceinline__ float gelu1(float v) { const pg8::f32x2 r = pg8::gelu_pk((pg8::f32x2){v, v}); return r.x; }
__device__ __forceinline__ void load_tile128(LAS bf16* dst, const bf16* src, int srcld, int tid) {
#pragma unroll
    for (int i = 0; i < 4; ++i) { const int ch = tid + 512 * i, r = ch >> 4, c8 = (ch & 15) * 8; *(LAS v4u*)(dst + r * LP + c8) = *(const GAS v4u*)(src + (size_t)r * srcld + c8); }
}
__device__ __forceinline__ void pool_item(const Frame& F, const bf16* P, bf16* MIX, const bf16* poolwt  , const float* pscale  , int tt, int g) {
    LAS bf16* As = (LAS bf16*)(F.lds); LAS bf16* Bs = As + 128 * LP; LAS bf16* raw = Bs + 128 * LP;
    const int tid = F.tid, row0 = tt * 128; const bool lat = row0 < ML;
    const int S = lat ? SEQ : CTXL, seqbase = lat ? (row0 & ~(SEQ - 1)) : ML + ((row0 - ML) & ~(CTXL - 1)), t0 = row0 - seqbase, half = 1 << g;
    for (int ch = tid; ch < 144 * 16; ch += 512) { const int rr = ch >> 4, c8 = (ch & 15) * 8, t = t0 - 8 + rr;
        v4u v = (v4u){0u, 0u, 0u, 0u}; if (t >= 0 && t < S) v = *(const GAS v4u*)(P + (size_t)(seqbase + t) * INW + C_POOL + g * 128 + c8);
        *(LAS v4u*)(raw + rr * 128 + c8) = v; }
    load_tile128(Bs, poolwt + (size_t)g * 16384, 128, tid);
    LDS_WAIT(); __syncthreads();
    { const int c = tid & 127, rg = tid >> 7; int t = t0 + rg * 32;
      float sum = 0.f; { const int lo = t - half < 0 ? 0 : t - half, hi = t + half > S ? S : t + half; for (int j = lo; j < hi; ++j) sum += bf2f(raw[(j - t0 + 8) * 128 + c]); }
      for (int i = 0; i < 32; ++i, ++t) {
          const int lo = t - half < 0 ? 0 : t - half, hi = t + half > S ? S : t + half;
          const float self = bf2f(raw[(t - t0 + 8) * 128 + c]);
          const float pooled = sum / (float)(hi - lo) - self;
          As[(rg * 32 + i) * LP + c] = (bf16)f2bf(pooled);
          if (t + half < S) sum += bf2f(raw[(t + half - t0 + 8) * 128 + c]);
          if (t - half >= 0) sum -= bf2f(raw[(t - half - t0 + 8) * 128 + c]);
      } }
    LDS_WAIT(); __syncthreads();
    const int w2 = F.wave >> 2, wc = F.wave & 3, fr = F.lane & 15, fq = F.lane >> 4;
    f32x4 acc[4][2]; mm128(As, Bs, acc, w2, wc, fr, fq);
#pragma unroll
    for (int n = 0; n < 2; ++n) { const int d = wc * 32 + n * 16 + 4 * fq; const f32x4 sc = *(const f32x4*)(pscale + g * 128 + d);
#pragma unroll
        for (int m = 0; m < 4; ++m) { const int r = row0 + w2 * 64 + m * 16 + fr; const f32x4 o = acc[m][n] * sc;
            *(GAS unsigned long long*)(MIX + (size_t)r * DM + 1024 + g * 128 + d) = (unsigned long long)pk2(o.x, o.y) | ((unsigned long long)pk2(o.z, o.w) << 32); } }
    __syncthreads();
}
__device__ __forceinline__ void sgu_item(const Frame& F, const bf16* P, bf16* MIX, const bf16* sguw  , const float* normg  , const float* sb  , int tt, int g) {
    LAS bf16* As = (LAS bf16*)(F.lds); LAS bf16* Bs = As + 128 * LP;
    const int tid = F.tid, row0 = tt * 128;
    load_tile128(As, sguw + (size_t)g * 16384, 128, tid);
    { const int q = tid >> 2, part = tid & 3; const bf16* zp = P + (size_t)(row0 + q) * INW + C_Z + g * 128 + part * 32;
      float z[32];
#pragma unroll
      for (int i = 0; i < 4; ++i) { const v4u w = *(const GAS v4u*)(zp + 8 * i);
#pragma unroll
          for (int j = 0; j < 4; ++j) { z[8 * i + 2 * j] = __uint_as_float(w[j] << 16); z[8 * i + 2 * j + 1] = __uint_as_float(w[j] & 0xffff0000u); } }
      float s = 0.f;
#pragma unroll
      for (int i = 0; i < 32; i += 2) { const pg8::f32x2 r = pg8::gelu_pk((pg8::f32x2){z[i], z[i + 1]}); z[i] = r.x; z[i + 1] = r.y; s += r.x + r.y; }
      s += __shfl_xor(s, 1); s += __shfl_xor(s, 2);
      const float mu = s * (1.0f / 128.0f); float q2 = 0.f;
#pragma unroll
      for (int i = 0; i < 32; ++i) { z[i] -= mu; q2 += z[i] * z[i]; }
      q2 += __shfl_xor(q2, 1); q2 += __shfl_xor(q2, 2);
      const float rstd = 1.0f / sqrtf(q2 * (1.0f / 128.0f) + EPS);
      const float* ng = normg + g * 128 + part * 32;
#pragma unroll
      for (int i = 0; i < 32; ++i) Bs[(part * 32 + i) * LP + q] = (bf16)f2bf(z[i] * rstd * ng[i]);
    }
    LDS_WAIT(); __syncthreads();
    const int w2 = F.wave >> 2, wc = F.wave & 3, fr = F.lane & 15, fq = F.lane >> 4;
    f32x4 acc[4][2]; mm128(As, Bs, acc, w2, wc, fr, fq);
#pragma unroll
    for (int m = 0; m < 4; ++m) { const int pr = w2 * 64 + m * 16 + fr, r = row0 + pr; const float bias = sb[g * 128 + pr];
#pragma unroll
        for (int n = 0; n < 2; ++n) { const int c = wc * 32 + n * 16 + 4 * fq;
            const unsigned long long uw = *(const GAS unsigned long long*)(P + (size_t)r * INW + C_U + g * 128 + c);
            const unsigned ulo = (unsigned)uw, uhi = (unsigned)(uw >> 32);
            const pg8::f32x2 ga = pg8::gelu_pk((pg8::f32x2){__uint_as_float(ulo << 16), __uint_as_float(ulo & 0xffff0000u)}), gb = pg8::gelu_pk((pg8::f32x2){__uint_as_float(uhi << 16), __uint_as_float(uhi & 0xffff0000u)});
            const f32x4 mx = acc[m][n] + bias;
            *(GAS unsigned long long*)(MIX + (size_t)r * DM + 1536 + g * 128 + c) = (unsigned long long)pk2(ga.x * mx.x, ga.y * mx.y) | ((unsigned long long)pk2(gb.x * mx.z, gb.y * mx.w) << 32); } }
    __syncthreads();
}

#ifndef REP_P1
#define REP_P1 1
#endif
#ifndef REP_P2
#define REP_P2 1
#endif
#ifndef REP_P3a
#define REP_P3a 1
#endif
#ifndef REP_P3b
#define REP_P3b 1
#endif
#ifndef REP_P4
#define REP_P4 1
#endif
#ifndef REP_P5
#define REP_P5 1
#endif
#ifndef REP_P6
#define REP_P6 1
#endif
#ifndef REP_P7
#define REP_P7 1
#endif
typedef const Params __attribute__((address_space(4))) KParams;
__device__ __forceinline__ KParams* kparams() { KParams* q = (KParams*)__builtin_amdgcn_kernarg_segment_ptr(); asm volatile("" : "+s"(q)); return q; }
__global__ void __launch_bounds__(NWAVES * 64, 2) fwd_kernel(Params p_unused) {
    extern __shared__ __attribute__((aligned(16))) unsigned char lds[];
    for (int u = threadIdx.x; u < (LDS_BYTES - LDSCTL_OFF) / 4; u += NWAVES * 64) ((LAS unsigned*)((LAS unsigned char*)lds + LDSCTL_OFF))[u] = 0u;
    __syncthreads();
    volatile LAS unsigned* MISC = (volatile LAS unsigned*)((LAS unsigned char*)lds + MISC_OFF);
    XcdBarrier bar;
    { KParams* kp = kparams(); const Frame F = mkframe((LAS unsigned char*)lds); bar = xcd_barrier_post((unsigned*)((gu32*)(kp->ws + WS_CTL) + CW_BAR), MISC + 8); }
#define GRID_BAR() xcd_barrier(bar)

    { KParams* kp = kparams(); const Frame F = mkframe((LAS unsigned char*)lds); prologue(F, kp); }
    GRID_BAR();

    for (int l = 0; l < DEPTH; ++l) {
        const bool last = (l == DEPTH - 1);
        const int Mrows = last ? ML : MT;
#ifndef NO_P1
        _Pragma("nounroll") for (int rep = 0; rep < REP_P1; ++rep) {
        { KParams* kp = kparams(); const Frame F = mkframe((LAS unsigned char*)lds); unsigned char* ws = kp->ws; float* X = (float*)(ws + WS_X); const float* mod = (const float*)(ws + WS_MOD);
          norm_phase(F, l == 0 ? kp->in[0] : X, l == 0 ? kp->in[2] : X + (size_t)ML * DM, kp->in[6] + (size_t)l * DM, mod + (size_t)l * 5 * 12288, 0, 1, (bf16*)(ws + WS_A), MT,
                     (l == 0 || rep + 1 < REP_P1) ? nullptr : (const float*)(ws + WS_SLAB), mod + (size_t)(l - 1) * 5 * 12288 + 4 * 12288 + 5 * DM, X + (size_t)ML * DM); }
        GRID_BAR(); }
#else
        GRID_BAR();
#endif
#ifndef NO_P2
        _Pragma("nounroll") for (int rep = 0; rep < REP_P2; ++rep) {
        { KParams* kp = kparams(); const Frame F = mkframe((LAS unsigned char*)lds); unsigned char* ws = kp->ws;
          pg8::Gemm g{(const bf16*)(ws + WS_A), (const bf16*)(ws + WS_WIN) + (size_t)l * INW * DM, MT, INW, DM}; pg8::StaticOrder S; S.init(MT, INW, F.G, (int)blockIdx.x, DM);
          pg8::EpiIn E{(bf16*)(ws + WS_P), (const float*)(ws + WS_ROPE)};
          pg8::gemm_phase<pg8::EpiIn, pg8::StaticOrder, true, true>(F.lds + RING_OFF, g, S, E);
          if (PRO_LAYERS == 1 && !last) steal_prep(F, kp, l + 1, (gu32*)(ws + WS_CTL) + CW_Q + (2 * l) * 64, 0, NCH_P2, (volatile LAS unsigned*)(F.lds + MISC_OFF)); }
        GRID_BAR(); }
#else
        GRID_BAR();
#endif
#ifndef NO_P3a
        _Pragma("nounroll") for (int rep = 0; rep < REP_P3a; ++rep) {
        { KParams* kp = kparams(); const Frame F = mkframe((LAS unsigned char*)lds); unsigned char* ws = kp->ws; const bf16* P = (const bf16*)(ws + WS_P); bf16* MIX = (bf16*)(ws + WS_MIX);
          const float* sink = kp->in[9] + l * 8; const int natt = last ? 256 : 288;
          for (int it = blockIdx.x; it < natt; it += F.G) {
              int qrow0w, qh, hk, rqw, nloc, jl0, kloc0, kctx0;
              if (it < 256) {
                  const int b = it >> 6, rem = it & 63, nq = rem >> 2, pair = rem & 1; hk = (rem >> 1) & 1;
                  qh = hk * 4 + pair * 2 + (F.wave >> 2); rqw = (F.wave & 3) * 32; jl0 = nq == 0 ? 2 : 0; nloc = (nq == 15 ? 3 : 5) - jl0 + 1;
                  qrow0w = b * SEQ + nq * 128 + rqw; kloc0 = b * SEQ + (nq - 1) * 128 + 64 * jl0; kctx0 = ML + b * CTXL;
              } else {
                  const int u = it - 256, b = u >> 3; qh = u & 7; hk = qh >> 2; rqw = 0; nloc = 0; jl0 = 2; kloc0 = 0; kctx0 = ML + b * CTXL; qrow0w = kctx0 + F.wave * 32;
              }
              att::attn_unit(P, MIX, qrow0w, qh, hk, rqw, sink[qh], nloc, jl0, kloc0, kctx0, (char*)lds + RING_OFF);
          } }
        if (rep + 1 < REP_P3a) GRID_BAR(); }
#endif
#ifndef NO_P3b
        _Pragma("nounroll") for (int rep = 0; rep < REP_P3b; ++rep) {
        { KParams* kp = kparams(); const Frame F = mkframe((LAS unsigned char*)lds); unsigned char* ws = kp->ws; const bf16* P = (const bf16*)(ws + WS_P); bf16* MIX = (bf16*)(ws + WS_MIX);
          const int nsmall = (last ? 64 : 72) * 8;
          const bf16* poolwt = (const bf16*)(ws + WS_POOLW) + (size_t)l * 4 * 16384; const bf16* sguw = (const bf16*)(ws + WS_SGUW) + (size_t)l * 4 * 16384;
          for (int s = (int)((blockIdx.x + F.G - 32) % F.G); s < nsmall; s += F.G) {
              const int tt = s >> 3, k = s & 7;
              if (k < 4) pool_item(F, P, MIX, poolwt, kp->in[11] + l * 512, tt, k);
              else sgu_item(F, P, MIX, sguw, kp->in[12] + l * 512, kp->in[14] + l * 512, tt, k - 4);
          } }
        GRID_BAR(); }
#else
        GRID_BAR();
#endif
#ifndef NO_P4
        _Pragma("nounroll") for (int rep = 0; rep < REP_P4; ++rep) {
        { KParams* kp = kparams(); const Frame F = mkframe((LAS unsigned char*)lds); unsigned char* ws = kp->ws; float* X = (float*)(ws + WS_X);
          pg8::Gemm g{(const bf16*)(ws + WS_MIX), (const bf16*)(ws + WS_WOUT) + (size_t)l * DM * DM, MT, DM, DM}; pg8::SplitOrder<false> S; S.init(ML, DM, F.G, (int)blockIdx.x, DM); S.nsplit = last ? 0 : 256;
          pg8::EpiRes E{l == 0 ? kp->in[0] : X, (rep + 1 < REP_P4) ? (float*)(ws + WS_END) : X, (float*)(ws + WS_SLAB), (const float*)(ws + WS_MOD) + (size_t)l * 5 * 12288, 2};
          pg8::gemm_phase<pg8::EpiRes, pg8::SplitOrder<false>, true, true>(F.lds + RING_OFF, g, S, E); }
        GRID_BAR(); }
#else
        GRID_BAR();
#endif
#ifndef NO_P5
        _Pragma("nounroll") for (int rep = 0; rep < REP_P5; ++rep) {
        { KParams* kp = kparams(); const Frame F = mkframe((LAS unsigned char*)lds); unsigned char* ws = kp->ws; float* X = (float*)(ws + WS_X); const float* modl = (const float*)(ws + WS_MOD) + (size_t)l * 5 * 12288;
          norm_phase(F, X, l == 0 ? kp->in[2] : X + (size_t)ML * DM, kp->in[7] + (size_t)l * DM, modl, 3, 4, (bf16*)(ws + WS_A), Mrows, (rep + 1 < REP_P5) ? nullptr : (const float*)(ws + WS_SLAB), modl + 4 * 12288 + 2 * DM, X + (size_t)ML * DM); }
        GRID_BAR(); }
#else
        GRID_BAR();
#endif
#ifndef NO_P6
        _Pragma("nounroll") for (int rep = 0; rep < REP_P6; ++rep) {
        { KParams* kp = kparams(); const Frame F = mkframe((LAS unsigned char*)lds); unsigned char* ws = kp->ws;
          pg8::Gemm g{(const bf16*)(ws + WS_A), (const bf16*)(ws + WS_WGU) + (size_t)l * 2 * DFF * DM, Mrows, 2 * DFF, DM}; pg8::StaticOrder S; S.init(Mrows, 2 * DFF, F.G, (int)blockIdx.x, DM);
          pg8::EpiSwiglu E{(bf16*)(ws + WS_ACT)};
          pg8::gemm_phase<pg8::EpiSwiglu, pg8::StaticOrder, true, true>(F.lds + RING_OFF, g, S, E);
          if (PRO_LAYERS == 1 && !last) { steal_prep(F, kp, l + 1, (gu32*)(ws + WS_CTL) + CW_Q + (2 * l) * 64, 0, NCH_P2, (volatile LAS unsigned*)(F.lds + MISC_OFF));
              steal_prep(F, kp, l + 1, (gu32*)(ws + WS_CTL) + CW_Q + (2 * l + 1) * 64, NCH_P2, NCH, (volatile LAS unsigned*)(F.lds + MISC_OFF)); } }
        GRID_BAR(); }
#else
        GRID_BAR();
#endif
#ifndef NO_P7
        _Pragma("nounroll") for (int rep = 0; rep < REP_P7; ++rep) {
        { KParams* kp = kparams(); const Frame F = mkframe((LAS unsigned char*)lds); unsigned char* ws = kp->ws; float* X = (float*)(ws + WS_X);
          pg8::Gemm g{(const bf16*)(ws + WS_ACT), (const bf16*)(ws + WS_WDN) + (size_t)l * DM * DFF, MT, DM, DFF}; pg8::SplitOrder<true> S; S.init(ML, DM, F.G, (int)blockIdx.x, DFF); S.nsplit = last ? 0 : 256;
          pg8::EpiRes E{X, (rep + 1 < REP_P7) ? (float*)(ws + WS_END) : X, (float*)(ws + WS_SLAB), (const float*)(ws + WS_MOD) + (size_t)l * 5 * 12288, 5};
          pg8::gemm_phase<pg8::EpiRes, pg8::SplitOrder<true>, true, true>(F.lds + RING_OFF, g, S, E); }
        GRID_BAR(); }
#else
        GRID_BAR();
#endif
    }
    { KParams* kp = kparams(); const Frame F = mkframe((LAS unsigned char*)lds); final_norm(F, (const float*)(kp->ws + WS_X), kp->in[18], kp->out); }
}

extern "C" void kernel_launch(void* const* d_in, const int* in_sizes, int n_in, void* d_out, int out_size, void* d_ws, size_t ws_size, hipStream_t stream) {
    static int grid = 0;
    if (grid == 0) {
        if (n_in != 19 || out_size != ML * DM || ws_size < WS_END) { fprintf(stderr, "kernel_launch: unexpected shapes (n_in %d out %d ws %zu, need ws >= %zu)\n", n_in, out_size, ws_size, (size_t)WS_END); grid = -1; return; }
        int dev = 0, cus = 0, per_cu = 0;
        if (hipGetDevice(&dev) != hipSuccess || hipDeviceGetAttribute(&cus, hipDeviceAttributeMultiprocessorCount, dev) != hipSuccess) { grid = -1; return; }
        if (hipFuncSetAttribute((const void*)fwd_kernel, hipFuncAttributeMaxDynamicSharedMemorySize, LDS_BYTES) != hipSuccess) { fprintf(stderr, "kernel_launch: hipFuncSetAttribute failed\n"); grid = -1; return; }
        if (hipOccupancyMaxActiveBlocksPerMultiprocessor(&per_cu, (const void*)fwd_kernel, NWAVES * 64, LDS_BYTES) != hipSuccess || per_cu < 1) { fprintf(stderr, "kernel_launch: occupancy query says %d\n", per_cu); }
        (void)hipGetLastError();
        grid = cus;
    }
    if (grid < 0) return;
    if (hipMemsetAsync((char*)d_ws + WS_CTL, 0, CTL_ZERO_BYTES, stream) != hipSuccess) return;
    Params p{};
    for (int i = 0; i < 19; ++i) p.in[i] = (const float*)d_in[i];
    p.out = (float*)d_out; p.ws = (unsigned char*)d_ws;
    hipLaunchKernelGGL(fwd_kernel, dim3(grid), dim3(NWAVES * 64), LDS_BYTES, stream, p);
}
```

```cpp
#include <hip/hip_runtime.h>
#include <cstdio>
#include <cstdint>
namespace pg8 {
#define PG8_LAS __attribute__((address_space(3)))
typedef unsigned short bf16_t;
typedef short bf16x8 __attribute__((ext_vector_type(8)));
typedef float f32x4 __attribute__((ext_vector_type(4)));
typedef unsigned u32x4 __attribute__((ext_vector_type(4)));
constexpr int BM = 256, BK = 64, HALF = 128, HTB = HALF * BK * 2  , STAGE_BYTES = 8 * HTB, NXCD = 8, WGM = 8;

__host__ __device__ __forceinline__ int lds_byte(int r, int c) { const int st = (r >> 4) * 2 + (c >> 5), rr = r & 15, cc = c & 31, ob = rr * 64 + cc * 2; return st * 1024 + (ob ^ (((ob >> 9) & 1) << 5)); }
__host__ __device__ __forceinline__ void stage_rc(int b, int& R, int& C) { const int st = b / 1024, sb = b % 1024, swz = sb ^ (((sb >> 9) & 1) << 5); R = (st >> 1) * 16 + swz / 64; C = (st & 1) * 32 + (swz % 64) / 2; }
__host__ __device__ __forceinline__ int perm32(int rho) { const int n = rho >> 4, i = rho & 15; return 8 * (i >> 2) + 4 * n + (i & 3); }

struct Unit { int pm, pn, k0b, nt, ks; };
struct Gemm { const bf16_t* A; const bf16_t* Bt; int M, N, K; };

struct StaticOrder {
    int nM, nN, nwg, G, c, ntf;
    __host__ __device__ __forceinline__ void init(int M, int N, int G_, int c_, int K) { nM = M / BM; nN = N / BM; nwg = nM * nN; G = G_; c = c_; ntf = K / BK; }
    __host__ __device__ __forceinline__ void map(int L, int& pm, int& pn) const {
        int wgid = L; { const int q = nwg / NXCD, r = nwg % NXCD, xcd = wgid % NXCD, off = wgid / NXCD; wgid = (xcd < r ? xcd * (q + 1) : r * (q + 1) + (xcd - r) * q) + off; }
        const int nig = WGM * nN, gid = wgid / nig, fm = gid * WGM, gsz = (nM - fm) < WGM ? (nM - fm) : WGM;
        pm = fm + ((wgid % nig) % gsz); pn = (wgid % nig) / gsz;
    }
    __host__ __device__ __forceinline__ bool next(int i, Unit& u) const {
        const int L = i * G + c; const bool ok = L < nwg; int pm = 0, pn = 0; if (ok) map(L, pm, pn);
        u = Unit{pm, pn, 0, ntf, -1}; return ok;
    }
    __device__ __forceinline__ void a_ready(const Unit&) const {}
    __device__ __forceinline__ void done(const Unit&) const {}
};
template <bool DOWN> struct SplitOrder : StaticOrder {
    int nsplit;
    __host__ __device__ __forceinline__ bool next(int i, Unit& u) const {
        const int L = i * G + c, s = L - nwg; const bool whole = L < nwg, ok = whole || s < nsplit;
        int pm = 0, pn = 0, k0b = 0, nt = ntf, ks = -1;
        if (whole) map(L, pm, pn);
        else if (ok) { const int tile = s >> 3; ks = s & 7; pm = 32 + (tile >> 3); pn = tile & 7;
            if (DOWN) { k0b = (ks < 6 ? ks * 768 : 4608 + (ks - 6) * 512) * 2; nt = ks < 6 ? 12 : 8; } else { k0b = ks * 256 * 2; nt = 4; } }
        u = Unit{pm, pn, k0b, nt, ks}; return ok;
    }
};


__device__ __forceinline__ unsigned cvt_pk_bf16(float lo, float hi) { unsigned r; asm volatile("v_cvt_pk_bf16_f32 %0, %1, %2" : "=v"(r) : "v"(lo), "v"(hi)); return r; }
typedef float f32x2 __attribute__((ext_vector_type(2)));
__device__ __forceinline__ f32x2 gelu_pk(f32x2 v) {
    const f32x2 av = __builtin_elementwise_abs(v), d = av * 0.2316418882f + 1.0f;
    f32x2 t; t.x = __builtin_amdgcn_rcpf(d.x); t.y = __builtin_amdgcn_rcpf(d.y);
    f32x2 q = t * 0.5307027145f + (-0.7265760135f); q = q * t + 0.7107068705f; q = q * t + (-0.142248368f); q = q * t + 0.127414796f; q = q * t;
    const f32x2 s = (v * v) * (-0.72134752044f);
    f32x2 e; e.x = __builtin_amdgcn_exp2f(s.x); e.y = __builtin_amdgcn_exp2f(s.y);
    const f32x2 m = v * (q * e), r = v - m;
    f32x2 o; o.x = v.x < 0.f ? m.x : r.x; o.y = v.y < 0.f ? m.y : r.y; return o;
}
struct EpiIn {
    static constexpr bool PERM = true, AFTER_DRAIN = false;
    bf16_t* P; const float* rope;
    __device__ __forceinline__ void operator()(const f32x4 (&acc)[2][2][4][2], const Unit& u, int wr, int wc, int fr, int fq) const {
        const int row0 = u.pm * BM + wr * 64 + fr;
        if (u.pn >= 5) {
            const int col0 = u.pn * BM + wc * 32 + 8 * fq;
#pragma unroll
            for (int ai = 0; ai < 2; ++ai)
#pragma unroll
                for (int m = 0; m < 4; ++m) { bf16_t* rowp = P + (size_t)(row0 + ai * HALF + m * 16) * 3072 + col0;
#pragma unroll
                    for (int bj = 0; bj < 2; ++bj) { f32x4 v0 = acc[ai][bj][m][0], v1 = acc[ai][bj][m][1];
                        if (u.pn >= 8) {
                            const f32x2 a = gelu_pk((f32x2){v0[0], v0[1]}), b = gelu_pk((f32x2){v0[2], v0[3]}), c = gelu_pk((f32x2){v1[0], v1[1]}), d = gelu_pk((f32x2){v1[2], v1[3]});
                            v0 = (f32x4){a.x, a.y, b.x, b.y}; v1 = (f32x4){c.x, c.y, d.x, d.y}; }
                        u32x4 w; w.x = cvt_pk_bf16(v0[0], v0[1]); w.y = cvt_pk_bf16(v0[2], v0[3]); w.z = cvt_pk_bf16(v1[0], v1[1]); w.w = cvt_pk_bf16(v1[2], v1[3]);
                        *(u32x4*)(rowp + bj * HALF) = w; } }
        } else {
            const int hl = wc >> 1, ax = wc & 1, i0 = 8 * fq, colb = u.pn * BM + hl * 128 + ax * 32 + i0;
            const bool rot = u.pm < 32;
#pragma unroll
            for (int ai = 0; ai < 2; ++ai)
#pragma unroll
                for (int m = 0; m < 4; ++m) { const int r = row0 + ai * HALF + m * 16;
                    f32x4 x1a = acc[ai][0][m][0], x1b = acc[ai][0][m][1], x2a = acc[ai][1][m][0], x2b = acc[ai][1][m][1];
                    if (rot) { const int s = r & 2047, pos = ax ? (s & 63) : (s >> 6); const float* cp = rope + pos * 32 + i0;
                        const f32x4 c0 = *(const f32x4*)cp, c1 = *(const f32x4*)(cp + 4), s0 = *(const f32x4*)(cp + 2048), s1 = *(const f32x4*)(cp + 2052);
                        const f32x4 o1a = x1a * c0 - x2a * s0, o1b = x1b * c1 - x2b * s1, o2a = x2a * c0 + x1a * s0, o2b = x2b * c1 + x1b * s1;
                        x1a = o1a; x1b = o1b; x2a = o2a; x2b = o2b; }
                    bf16_t* rowp = P + (size_t)r * 3072 + colb;
                    u32x4 w; w.x = cvt_pk_bf16(x1a[0], x1a[1]); w.y = cvt_pk_bf16(x1a[2], x1a[3]); w.z = cvt_pk_bf16(x1b[0], x1b[1]); w.w = cvt_pk_bf16(x1b[2], x1b[3]);
                    *(u32x4*)rowp = w;
                    w.x = cvt_pk_bf16(x2a[0], x2a[1]); w.y = cvt_pk_bf16(x2a[2], x2a[3]); w.z = cvt_pk_bf16(x2b[0], x2b[1]); w.w = cvt_pk_bf16(x2b[2], x2b[3]);
                    *(u32x4*)(rowp + 64) = w; }
        }
    }
};
struct EpiRes {
    static constexpr bool PERM = false, AFTER_DRAIN = false;
    const float* base_lat; float* X; float* slab; const float* modl; int gidx;
    __device__ __forceinline__ void operator()(const f32x4 (&acc)[2][2][4][2], const Unit& u, int wr, int wc, int fr, int fq) const {
        const int row0 = u.pm * BM + wr * 64 + fr, col0 = u.pn * BM + wc * 32 + 4 * fq;
        if (u.ks >= 0) {
            float* sp0 = slab + ((size_t)u.ks * 1024 + (row0 - 8192)) * 2048 + col0;
#pragma unroll
            for (int ai = 0; ai < 2; ++ai)
#pragma unroll
                for (int m = 0; m < 4; ++m) { float* sp = sp0 + (size_t)(ai * HALF + m * 16) * 2048;
#pragma unroll
                    for (int bj = 0; bj < 2; ++bj)
#pragma unroll
                        for (int n = 0; n < 2; ++n) *(f32x4*)(sp + bj * HALF + n * 16) = acc[ai][bj][m][n]; }
            return;
        }
        const float* gate = modl + (u.pm >> 3) * 12288 + gidx * 2048 + col0;
        const float* bp0 = base_lat + (size_t)row0 * 2048;
        f32x4 gv[2][2];
#pragma unroll
        for (int bj = 0; bj < 2; ++bj)
#pragma unroll
            for (int n = 0; n < 2; ++n) gv[bj][n] = *(const f32x4*)(gate + bj * HALF + n * 16);
#pragma unroll
        for (int ai = 0; ai < 2; ++ai)
#pragma unroll
            for (int m = 0; m < 4; ++m) { const size_t ro = (size_t)(ai * HALF + m * 16) * 2048 + col0; const float* bp = bp0 + ro; float* xp = X + (size_t)row0 * 2048 + ro;
#pragma unroll
                for (int bj = 0; bj < 2; ++bj)
#pragma unroll
                    for (int n = 0; n < 2; ++n) { const f32x4 bs = *(const f32x4*)(bp + bj * HALF + n * 16); *(f32x4*)(xp + bj * HALF + n * 16) = bs + gv[bj][n] * acc[ai][bj][m][n]; }
                asm volatile("" ::: "memory"); }
    }
};
struct EpiSwiglu {
    static constexpr bool PERM = true, AFTER_DRAIN = false;
    bf16_t* ACT;
    __device__ __forceinline__ static float sw(float g, float up) { return g * __builtin_amdgcn_rcpf(1.0f + __builtin_amdgcn_exp2f(g * -1.4426950408889634f)) * up; }
    __device__ __forceinline__ void operator()(const f32x4 (&acc)[2][2][4][2], const Unit& u, int wr, int wc, int fr, int fq) const {
        const int row0 = u.pm * BM + wr * 64 + fr, col0 = u.pn * 128 + wc * 32 + 8 * fq;
#pragma unroll
        for (int ai = 0; ai < 2; ++ai)
#pragma unroll
            for (int m = 0; m < 4; ++m) { bf16_t* rowp = ACT + (size_t)(row0 + ai * HALF + m * 16) * 5632 + col0;
                const f32x4 g0 = acc[ai][0][m][0], g1 = acc[ai][0][m][1], u0 = acc[ai][1][m][0], u1 = acc[ai][1][m][1];
                u32x4 w; w.x = cvt_pk_bf16(sw(g0[0], u0[0]), sw(g0[1], u0[1])); w.y = cvt_pk_bf16(sw(g0[2], u0[2]), sw(g0[3], u0[3]));
                w.z = cvt_pk_bf16(sw(g1[0], u1[0]), sw(g1[1], u1[1])); w.w = cvt_pk_bf16(sw(g1[2], u1[2]), sw(g1[3], u1[3]));
                *(u32x4*)rowp = w; }
    }
};
template <class Epi, class Sched, bool ALIGN_EPI = false, bool SP2 = false>
__device__ __forceinline__ void gemm_phase(PG8_LAS unsigned char* lds, const Gemm g, const Sched& S, const Epi& E) {
    int tid_ = threadIdx.x; asm volatile("" : "+v"(tid_));
    const int tid = tid_, wid = __builtin_amdgcn_readfirstlane(tid >> 6), lane = tid & 63, wr = wid >> 2, wc = wid & 3, fr = lane & 15, fq = lane >> 4;
    const int K = g.K;
    unsigned voffA[2], voffB[2];
#pragma unroll
    for (int i = 0; i < 2; ++i) { int R, C; stage_rc(tid * 16 + i * 8192, R, C); const int Rb = Epi::PERM ? ((R & ~31) + perm32(R & 31)) : R;
        voffA[i] = (unsigned)(R * K + C) * 2u; voffB[i] = (unsigned)(Rb * K + C) * 2u; }
    const size_t kstep = (size_t)(BK * 2);
    const size_t hstep = (size_t)HALF * K * 2;
    const size_t tstep = 2 * hstep;
    const unsigned ldsw = (unsigned)wid * 1024u;
    const int aoff = lds_byte(wr * 64 + fr, fq * 8), boff = lds_byte(wc * 32 + fr, fq * 8);
#define PG8_SA(b, h) (((b) * 2 + (h)) * HTB)
#define PG8_SB(b, h) ((4 + (b) * 2 + (h)) * HTB)
#define PG8_STAGE(bufoff, gbase, voff) do { _Pragma("unroll") for (int _i = 0; _i < 2; ++_i) \
        __builtin_amdgcn_global_load_lds((const unsigned*)((const char*)(gbase) + (voff)[_i]), (PG8_LAS unsigned*)(lds + (bufoff) + ldsw + _i * 8192), 16, 0, 0); } while (0)
#define PG8_LDA(dst, b, h) do { _Pragma("unroll") for (int m = 0; m < 4; ++m) _Pragma("unroll") for (int k = 0; k < 2; ++k) dst[m][k] = *(const PG8_LAS bf16x8*)(lds + PG8_SA(b, h) + aoff + m * 2048 + k * 1024); } while (0)
#define PG8_LDB(dst, b, h) do { _Pragma("unroll") for (int n = 0; n < 2; ++n) _Pragma("unroll") for (int k = 0; k < 2; ++k) dst[n][k] = *(const PG8_LAS bf16x8*)(lds + PG8_SB(b, h) + boff + n * 2048 + k * 1024); } while (0)
#define PG8_MMA(ai, bj, At, Bt) do { __builtin_amdgcn_s_setprio(1); _Pragma("unroll") for (int m = 0; m < 4; ++m) _Pragma("unroll") for (int n = 0; n < 2; ++n) _Pragma("unroll") for (int k = 0; k < 2; ++k) \
        acc[ai][bj][m][n] = __builtin_amdgcn_mfma_f32_16x16x32_bf16(Bt[n][k], At[m][k], acc[ai][bj][m][n], 0, 0, 0); __builtin_amdgcn_s_setprio(0); } while (0)
#define PG8_WAIT_V(n) asm volatile("s_waitcnt vmcnt(" #n ")" ::: "memory")
#define PG8_WAIT_L(n) asm volatile("s_waitcnt lgkmcnt(" #n ")" ::: "memory")
#define PG8_BAR __builtin_amdgcn_s_barrier()
#define PG8_SCHED __builtin_amdgcn_sched_barrier(0)
    Unit cur, nxt; int ui = 0;
    if (!S.next(0, cur)) return;
    f32x4 acc[2][2][4][2];
#pragma unroll
    for (int a = 0; a < 2; ++a)
#pragma unroll
        for (int b = 0; b < 2; ++b)
#pragma unroll
            for (int m = 0; m < 4; ++m)
#pragma unroll
                for (int n = 0; n < 2; ++n) acc[a][b][m][n] = (f32x4){0.f, 0.f, 0.f, 0.f};
    bf16x8 At[4][2], B0[2][2], B1[2][2];
    const char* cA = (const char*)g.A + (size_t)cur.pm * tstep + cur.k0b; const char* cB = (const char*)g.Bt + (size_t)cur.pn * tstep + cur.k0b;
    S.a_ready(cur);
    if constexpr (SP2) {
        PG8_STAGE(PG8_SB(0, 0), cB, voffB); PG8_STAGE(PG8_SB(0, 1), cB + hstep, voffB); PG8_STAGE(PG8_SA(0, 0), cA, voffA); PG8_STAGE(PG8_SA(0, 1), cA + hstep, voffA);
        if (wr == 1) PG8_BAR;
        PG8_WAIT_V(2); PG8_BAR;
        PG8_STAGE(PG8_SB(1, 0), cB + kstep, voffB); PG8_STAGE(PG8_SA(1, 0), cA + kstep, voffA); PG8_STAGE(PG8_SB(1, 1), cB + hstep + kstep, voffB);
        PG8_WAIT_V(6); PG8_BAR;
    } else {
        PG8_STAGE(PG8_SB(0, 0), cB, voffB); PG8_STAGE(PG8_SA(0, 0), cA, voffA); PG8_STAGE(PG8_SB(0, 1), cB + hstep, voffB); PG8_STAGE(PG8_SA(0, 1), cA + hstep, voffA);
        if (wr == 1) PG8_BAR;
        PG8_WAIT_V(4); PG8_BAR;
        PG8_STAGE(PG8_SB(1, 0), cB + kstep, voffB); PG8_STAGE(PG8_SA(1, 0), cA + kstep, voffA); PG8_STAGE(PG8_SB(1, 1), cB + hstep + kstep, voffB);
        PG8_WAIT_V(6); PG8_BAR;
    }
    for (;;) {
        const bool has_next = S.next(ui + 1, nxt);
        const char* nA = has_next ? (const char*)g.A + (size_t)nxt.pm * tstep + nxt.k0b : cA; const char* nB = has_next ? (const char*)g.Bt + (size_t)nxt.pn * tstep + nxt.k0b : cB;
        const int nt = cur.nt;
        for (int t = 0; t < nt; t += 2) {
            const bool last = (t == nt - 2);
            const char* a1 = cA + (size_t)(t + 1) * kstep;
            const char* a2 = last ? nA : cA + (size_t)(t + 2) * kstep; const char* b2 = last ? nB : cB + (size_t)(t + 2) * kstep;
            const char* a3 = a2 + kstep; const char* b3 = b2 + kstep;
            if (last && has_next) S.a_ready(nxt);
            if constexpr (SP2) {
            PG8_LDB(B0, 0, 0); PG8_LDB(B1, 0, 1); PG8_SCHED; PG8_LDA(At, 0, 0); PG8_STAGE(PG8_SA(1, 1), a1 + hstep, voffA);
            PG8_WAIT_V(8); PG8_WAIT_L(0); PG8_BAR; PG8_MMA(0, 0, At, B0); PG8_MMA(0, 1, At, B1); PG8_BAR; PG8_SCHED;
            PG8_LDA(At, 0, 1); PG8_STAGE(PG8_SB(0, 0), b2, voffB); PG8_STAGE(PG8_SB(0, 1), b2 + hstep, voffB); PG8_STAGE(PG8_SA(0, 0), a2, voffA);
            PG8_WAIT_V(8); PG8_WAIT_L(0); PG8_BAR; PG8_MMA(1, 0, At, B0); PG8_MMA(1, 1, At, B1); PG8_BAR; PG8_SCHED;
            PG8_LDB(B0, 1, 0); PG8_LDB(B1, 1, 1); PG8_SCHED; PG8_LDA(At, 1, 0); PG8_STAGE(PG8_SA(0, 1), a2 + hstep, voffA);
            PG8_WAIT_V(8); PG8_WAIT_L(0); PG8_BAR; PG8_MMA(0, 0, At, B0); PG8_MMA(0, 1, At, B1); PG8_BAR; PG8_SCHED;
            PG8_LDA(At, 1, 1); PG8_STAGE(PG8_SB(1, 0), b3, voffB); PG8_STAGE(PG8_SB(1, 1), b3 + hstep, voffB); PG8_STAGE(PG8_SA(1, 0), a3, voffA);
            PG8_WAIT_V(8); PG8_WAIT_L(0); PG8_BAR; PG8_MMA(1, 0, At, B0); PG8_MMA(1, 1, At, B1); PG8_BAR; PG8_SCHED;
            } else {
            PG8_LDB(B0, 0, 0); PG8_SCHED; PG8_LDA(At, 0, 0); PG8_STAGE(PG8_SA(1, 1), a1 + hstep, voffA);
            PG8_WAIT_L(8); PG8_BAR; PG8_WAIT_L(0); PG8_MMA(0, 0, At, B0); PG8_BAR; PG8_SCHED;
            PG8_LDB(B1, 0, 1); PG8_STAGE(PG8_SB(0, 0), b2, voffB);
            PG8_BAR; PG8_WAIT_L(0); PG8_MMA(0, 1, At, B1); PG8_BAR;
            PG8_LDA(At, 0, 1); PG8_STAGE(PG8_SA(0, 0), a2, voffA);
            PG8_BAR; PG8_WAIT_L(0); PG8_MMA(1, 0, At, B0); PG8_BAR; PG8_SCHED;
            PG8_STAGE(PG8_SB(0, 1), b2 + hstep, voffB);
            PG8_WAIT_V(6); PG8_BAR; PG8_MMA(1, 1, At, B1); PG8_BAR;
            PG8_LDB(B0, 1, 0); PG8_SCHED; PG8_LDA(At, 1, 0); PG8_STAGE(PG8_SA(0, 1), a2 + hstep, voffA);
            PG8_WAIT_L(8); PG8_BAR; PG8_WAIT_L(0); PG8_MMA(0, 0, At, B0); PG8_BAR; PG8_SCHED;
            PG8_LDB(B1, 1, 1); PG8_STAGE(PG8_SB(1, 0), b3, voffB);
            PG8_BAR; PG8_WAIT_L(0); PG8_MMA(0, 1, At, B1); PG8_BAR;
            PG8_LDA(At, 1, 1); PG8_STAGE(PG8_SA(1, 0), a3, voffA);
            PG8_BAR; PG8_WAIT_L(0); PG8_MMA(1, 0, At, B0); PG8_BAR; PG8_SCHED;
            PG8_STAGE(PG8_SB(1, 1), b3 + hstep, voffB);
            PG8_WAIT_V(6); PG8_BAR; PG8_MMA(1, 1, At, B1); PG8_BAR;
            }
        }
        if constexpr (ALIGN_EPI) { if (wr == 0) PG8_BAR; }
        if constexpr (!Epi::AFTER_DRAIN) { E(acc, cur, wr, wc, fr, fq); S.done(cur); }
        if (!has_next) break;
#pragma unroll
        for (int a = 0; a < 2; ++a)
#pragma unroll
            for (int b = 0; b < 2; ++b)
#pragma unroll
                for (int m = 0; m < 4; ++m)
#pragma unroll
                    for (int n = 0; n < 2; ++n) acc[a][b][m][n] = (f32x4){0.f, 0.f, 0.f, 0.f};
        cur = nxt; cA = nA; cB = nB; ++ui;
        if constexpr (ALIGN_EPI) { if (wr == 1) PG8_BAR; }
    }
    PG8_WAIT_V(0);
    if constexpr (!ALIGN_EPI) { if (wr == 0) PG8_BAR; }
    PG8_BAR;
    if constexpr (Epi::AFTER_DRAIN) { E.fused(acc, cur, wr, wc, fr, fq, lds, wid, lane); S.done(cur); }
#undef PG8_SA
#undef PG8_SB
#undef PG8_STAGE
#undef PG8_LDA
#undef PG8_LDB
#undef PG8_MMA
#undef PG8_WAIT_V
#undef PG8_WAIT_L
#undef PG8_BAR
#undef PG8_SCHED
}
}
namespace att {
using bf16x8 = __attribute__((ext_vector_type(8))) short;
using s16x4  = __attribute__((ext_vector_type(4))) short;
using f32x16 = __attribute__((ext_vector_type(16))) float;
using u32x4  = __attribute__((ext_vector_type(4))) unsigned;
typedef unsigned short bf16;
constexpr int D = 128, NW = 8, QBLK = 32, KVBLK = 64, LDP = 3072;
constexpr float SCALE = 0.088388347648318440f;
constexpr float THR = 8.f;
constexpr size_t SHM_V = KVBLK * D * 2, SHM_K = KVBLK * D * 2, SHM_ATTN = 2 * SHM_V + 2 * SHM_K + NW * 64 * 4;
#define KSWZ(row, colB) ((row) * 256 + ((colB) ^ (((row) & 7) << 4)))
#define SBAR() __builtin_amdgcn_sched_barrier(0)
__device__ __forceinline__ int crow(int r, int hi) { return (r & 3) + 8 * (r >> 2) + 4 * hi; }
__device__ __forceinline__ unsigned cvtpk(float lo, float hi) { unsigned r; asm volatile("v_cvt_pk_bf16_f32 %0, %1, %2" : "=v"(r) : "v"(lo), "v"(hi)); return r; }
__device__ __forceinline__ void maskSM(f32x16& p0, f32x16& p1, int lob, int hib) {
#pragma unroll
  for (int r = 0; r < 16; ++r) { const int kk = (r & 3) + 8 * (r >> 2); p0[r] = (kk < lob || kk > hib) ? -1e30f : p0[r]; p1[r] = (kk + 32 < lob || kk + 32 > hib) ? -1e30f : p1[r]; }
}
__device__ __forceinline__ void partialSM(f32x16& p0, f32x16& p1, float& m_reg, float& mn, float& alpha) {
  constexpr float C = SCALE * 1.4426950408889634f;
  float pmax = p0[0];
#pragma unroll
  for (int r = 1; r < 16; ++r) pmax = fmaxf(pmax, p0[r]);
#pragma unroll
  for (int r = 0; r < 16; ++r) pmax = fmaxf(pmax, p1[r]);
  { auto rr = __builtin_amdgcn_permlane32_swap(__float_as_uint(pmax), __float_as_uint(pmax), false, false);
    pmax = fmaxf(__uint_as_float(rr[0]), __uint_as_float(rr[1])); }
  if (__builtin_expect(__all(pmax - m_reg <= THR / SCALE), 1)) { mn = m_reg; alpha = 1.f; }
  else { mn = fmaxf(m_reg, pmax); alpha = __builtin_amdgcn_exp2f((m_reg - mn) * C); m_reg = mn; }
  float mnC = -mn * C;
#pragma unroll
  for (int r = 0; r < 16; ++r) p0[r] = fmaf(p0[r], C, mnC);
#pragma unroll
  for (int r = 0; r < 16; ++r) p1[r] = fmaf(p1[r], C, mnC);
#pragma unroll
  for (int r = 0; r < 16; ++r) p0[r] = __builtin_amdgcn_exp2f(p0[r]);
}
__device__ __forceinline__ void finishSM(f32x16& p0, f32x16& p1, float alpha, float& l_reg, bf16x8& pa0, bf16x8& pa1, bf16x8& pa2, bf16x8& pa3) {
#pragma unroll
  for (int r = 0; r < 16; ++r) p1[r] = __builtin_amdgcn_exp2f(p1[r]);
  float ps = 0;
#pragma unroll
  for (int r = 0; r < 16; ++r) ps += p0[r];
#pragma unroll
  for (int r = 0; r < 16; ++r) ps += p1[r];
  { auto rr = __builtin_amdgcn_permlane32_swap(__float_as_uint(ps), __float_as_uint(ps), false, false);
    ps = __uint_as_float(rr[0]) + __uint_as_float(rr[1]); }
  l_reg = l_reg * alpha + ps;
#define PK4(P, BASE, OUT) do { unsigned a0 = cvtpk(P[BASE + 0], P[BASE + 1]), a1 = cvtpk(P[BASE + 2], P[BASE + 3]);   \
    unsigned b0 = cvtpk(P[BASE + 4], P[BASE + 5]), b1 = cvtpk(P[BASE + 6], P[BASE + 7]);                              \
    auto r0 = __builtin_amdgcn_permlane32_swap(a0, b0, false, false); auto r1 = __builtin_amdgcn_permlane32_swap(a1, b1, false, false); \
    u32x4 w = {r0[0], r1[0], r0[1], r1[1]}; OUT = *reinterpret_cast<bf16x8*>(&w); } while (0)
  PK4(p0, 0, pa0); PK4(p0, 8, pa1); PK4(p1, 0, pa2); PK4(p1, 8, pa3);
#undef PK4
}
__device__ __forceinline__ void qkt(f32x16& p0, f32x16& p1, const char* Ks, const bf16x8* qr, int r32, int hi) {
  p0 = f32x16{}; p1 = f32x16{};
#pragma unroll
  for (int d0 = 0; d0 < 8; ++d0) { int cb = (d0 * 16 + hi * 8) * 2;
    bf16x8 b0 = *reinterpret_cast<const bf16x8*>(Ks + KSWZ(r32, cb));
    bf16x8 b1 = *reinterpret_cast<const bf16x8*>(Ks + KSWZ(32 + r32, cb));
    p0 = __builtin_amdgcn_mfma_f32_32x32x16_bf16(b0, qr[d0], p0, 0, 0, 0);
    p1 = __builtin_amdgcn_mfma_f32_32x32x16_bf16(b1, qr[d0], p1, 0, 0, 0); }
}
__device__ __forceinline__ int v_st(int k, int c) { const int kk = (k & ~0xC) | ((k & 4) << 1) | ((k & 8) >> 1); return ((kk >> 3) * 4 + (c >> 5)) * 512 + ((kk & 7) * 32 + (c & 31)) * 2; }
__device__ __forceinline__ int v_rd_base(int lane) { return ((lane & 3) << 3) | (((lane >> 2) & 3) << 6) | (((lane >> 4) & 1) << 5) | (((lane >> 5) & 1) << 8); }
constexpr int v_rd_off(int d0, int ks, int half) { return d0 * 512 + ks * 4096 + half * 2048; }
template <int OFF> __device__ __forceinline__ s16x4 tr_read(int vb) {
  s16x4 r; asm volatile("ds_read_b64_tr_b16 %0, %1 offset:%2" : "=&v"(r) : "v"(vb), "i"(OFF) : "memory"); return r;
}
template <int D0> __device__ __forceinline__ void pv_one(f32x16& od, int vb, bf16x8 pa0, bf16x8 pa1, bf16x8 pa2, bf16x8 pa3) {
  const s16x4 l0 = tr_read<v_rd_off(D0, 0, 0)>(vb), h0 = tr_read<v_rd_off(D0, 0, 1)>(vb), l1 = tr_read<v_rd_off(D0, 1, 0)>(vb), h1 = tr_read<v_rd_off(D0, 1, 1)>(vb);
  const s16x4 l2 = tr_read<v_rd_off(D0, 2, 0)>(vb), h2 = tr_read<v_rd_off(D0, 2, 1)>(vb), l3 = tr_read<v_rd_off(D0, 3, 0)>(vb), h3 = tr_read<v_rd_off(D0, 3, 1)>(vb);
  asm volatile("s_waitcnt lgkmcnt(0)" ::: "memory"); SBAR();
#define PK(L, H) (bf16x8){L[0], L[1], L[2], L[3], H[0], H[1], H[2], H[3]}
  od = __builtin_amdgcn_mfma_f32_32x32x16_bf16(pa0, PK(l0, h0), od, 0, 0, 0);
  od = __builtin_amdgcn_mfma_f32_32x32x16_bf16(pa1, PK(l1, h1), od, 0, 0, 0);
  od = __builtin_amdgcn_mfma_f32_32x32x16_bf16(pa2, PK(l2, h2), od, 0, 0, 0);
  od = __builtin_amdgcn_mfma_f32_32x32x16_bf16(pa3, PK(l3, h3), od, 0, 0, 0);
#undef PK
}
__device__ __forceinline__ void pv_d0(f32x16* o, int vb, bf16x8 pa0, bf16x8 pa1, bf16x8 pa2, bf16x8 pa3) {
  pv_one<0>(o[0], vb, pa0, pa1, pa2, pa3); pv_one<1>(o[1], vb, pa0, pa1, pa2, pa3); pv_one<2>(o[2], vb, pa0, pa1, pa2, pa3); pv_one<3>(o[3], vb, pa0, pa1, pa2, pa3);
}
__device__ __forceinline__ void attn_unit(const bf16* __restrict__ P, bf16* __restrict__ MIX, int qrow0w, int qh, int hk, int rqw, float sinkv,
                                          int nloc, int jl0, int kloc0, int kctx0, char* lds) {
  int tid_ = threadIdx.x; asm volatile("" : "+v"(tid_));
  const int tid = tid_, wid = tid >> 6, lane = tid & 63, r32 = lane & 31, hi = lane >> 5;
  char* V_lds = lds; char* K_lds = lds + 2 * SHM_V;
  float* ws = (float*)(lds + 2 * SHM_V + 2 * SHM_K) + wid * 64; float* li_l = ws; float* al_l = ws + 32;
  float m_reg = sinkv * (1.0f / SCALE), l_reg = 1.0f; f32x16 o[4] = {}; bf16x8 qr[8];
  const bf16* Qw = P + (size_t)(qrow0w + r32) * LDP + qh * 128 + hi * 8;
#pragma unroll
  for (int d0 = 0; d0 < 8; ++d0) qr[d0] = *reinterpret_cast<const bf16x8*>(Qw + d0 * 16);
  const int sr = tid >> 4, sc = (tid & 15) * 8, vst0 = v_st(sr, sc), vst1 = v_st(32 + sr, sc);
  const int vb0 = (int)(uintptr_t)V_lds + v_rd_base(lane);
  const int rq = rqw + r32, NT = nloc + 4;
  const unsigned loff = (unsigned)(sr * LDP + sc) * 2u;
  const char* KVb = (const char*)P + (size_t)(1024 + hk * 128) * 2;
  struct { bf16x8 vs0, vs1, ks0, ks1; } sr_[2];
#define TROW(t) ((t) < nloc ? kloc0 + 64 * (t) : kctx0 + 64 * ((t) - nloc))
#define SLOAD(i, t) do { const char* b0_ = KVb + (size_t)TROW(t) * (LDP * 2); const char* b1_ = b0_ + 32 * LDP * 2; \
    sr_[i].vs0 = *reinterpret_cast<const bf16x8*>(b0_ + 512 + loff); sr_[i].vs1 = *reinterpret_cast<const bf16x8*>(b1_ + 512 + loff); \
    sr_[i].ks0 = *reinterpret_cast<const bf16x8*>(b0_ + loff); sr_[i].ks1 = *reinterpret_cast<const bf16x8*>(b1_ + loff); } while (0)
#define SWRITE(b, i) do { *(bf16x8*)(V_lds + (b) * SHM_V + vst0) = sr_[i].vs0; *(bf16x8*)(V_lds + (b) * SHM_V + vst1) = sr_[i].vs1; int kc = sc * 2; \
    *(bf16x8*)(K_lds + (b) * SHM_K + KSWZ(sr, kc)) = sr_[i].ks0; *(bf16x8*)(K_lds + (b) * SHM_K + KSWZ(32 + sr, kc)) = sr_[i].ks1; } while (0)
#define SWAIT() asm volatile("s_waitcnt vmcnt(4)" ::: "memory")
#define RESC(a) do { if (__any((a) < 1.f)) { if (hi == 0) al_l[r32] = (a); asm volatile("s_waitcnt lgkmcnt(0)" ::: "memory"); \
    _Pragma("unroll") for (int d = 0; d < 4; ++d) _Pragma("unroll") for (int r = 0; r < 16; ++r) o[d][r] *= al_l[crow(r, hi)]; } } while (0)
#define MASK(pa, pb, t) do { if ((t) < nloc) { const int jl_ = jl0 + (t); if (jl_ < 2 || jl_ > 3) { \
    const int lob_ = (jl_ == 0 ? rq : (jl_ == 1 ? rq - 64 : -1)) - 4 * hi, hib_ = (jl_ == 4 ? rq : (jl_ == 5 ? rq - 64 : 64)) - 4 * hi; maskSM(pa, pb, lob_, hib_); } } } while (0)
  f32x16 pA0, pA1, pB0, pB1; float mnA, mnB, alA, alB; bf16x8 pa0, pa1, pa2, pa3;
  SLOAD(0, 0); asm volatile("s_waitcnt vmcnt(0)" ::: "memory"); SWRITE(0, 0); __syncthreads();
  qkt(pA0, pA1, K_lds, qr, r32, hi); MASK(pA0, pA1, 0); partialSM(pA0, pA1, m_reg, mnA, alA);
  SLOAD(1, 1); if (2 < NT) SLOAD(0, 2);
  SWAIT(); SWRITE(1, 1); __syncthreads();
  for (int j = 1; j + 1 < NT; j += 2) {
    SBAR(); qkt(pB0, pB1, K_lds + SHM_K, qr, r32, hi); MASK(pB0, pB1, j);
    finishSM(pA0, pA1, alA, l_reg, pa0, pa1, pa2, pa3); SBAR();
    SLOAD(1, j + 2); SBAR();
    pv_d0(o, vb0, pa0, pa1, pa2, pa3); partialSM(pB0, pB1, m_reg, mnB, alB);
    __syncthreads(); SWAIT(); SWRITE(0, 0);
    RESC(alB); __syncthreads();
    SBAR(); qkt(pA0, pA1, K_lds, qr, r32, hi); MASK(pA0, pA1, j + 1);
    finishSM(pB0, pB1, alB, l_reg, pa0, pa1, pa2, pa3); SBAR();
    if (j + 3 < NT) SLOAD(0, j + 3); SBAR();
    pv_d0(o, vb0 + (int)SHM_V, pa0, pa1, pa2, pa3); partialSM(pA0, pA1, m_reg, mnA, alA);
    __syncthreads(); SWAIT(); SWRITE(1, 1);
    RESC(alA); __syncthreads();
  }
  SBAR(); qkt(pB0, pB1, K_lds + SHM_K, qr, r32, hi); MASK(pB0, pB1, NT - 1);
  finishSM(pA0, pA1, alA, l_reg, pa0, pa1, pa2, pa3); SBAR();
  pv_d0(o, vb0, pa0, pa1, pa2, pa3); partialSM(pB0, pB1, m_reg, mnB, alB);
  __syncthreads(); RESC(alB);
  finishSM(pB0, pB1, alB, l_reg, pa0, pa1, pa2, pa3); SBAR();
  pv_d0(o, vb0 + (int)SHM_V, pa0, pa1, pa2, pa3);
  if (hi == 0) li_l[r32] = l_reg; asm volatile("s_waitcnt lgkmcnt(0)" ::: "memory");
  float rli[16];
#pragma unroll
  for (int r = 0; r < 16; ++r) rli[r] = __builtin_amdgcn_rcpf(li_l[crow(r, hi)]);
  bf16* Ow = MIX + (size_t)qrow0w * 2048 + qh * 128 + r32;
#pragma unroll
  for (int r = 0; r < 16; ++r) { const int orow = crow(r, hi);
#pragma unroll
    for (int d0 = 0; d0 < 4; ++d0) { const float v = o[d0][r] * rli[r]; unsigned u = __float_as_uint(v); u = (u + 0x7fffu + ((u >> 16) & 1u)) >> 16; Ow[(size_t)orow * 2048 + d0 * 32] = (bf16)u; } }
  __syncthreads();
#undef TROW
#undef SLOAD
#undef SWRITE
#undef SWAIT
#undef RESC
#undef MASK
}
#undef KSWZ
#undef SBAR
}
constexpr int DM = 2048, NB = 4, SEQ = 2048, DEPTH = 4, CTXL = 256, INW = 3072, DFF = 5632;
constexpr int ML = NB * SEQ, MC = NB * CTXL, MT = ML + MC;
constexpr int C_Q = 0, C_K = 1024, C_V = 1280, C_POOL = 1536, C_U = 2048, C_Z = 2560;
constexpr float EPS = 1e-6f;
constexpr int NWAVES = 8;
constexpr size_t MiB = 1u << 20;
constexpr size_t WS_CTL = 0, CTL_ZERO_BYTES = 2 * MiB;
constexpr size_t WS_MOD = 1 * MiB;
constexpr size_t WS_ROPE = 2 * MiB;
constexpr size_t WS_POOLW = 2 * MiB + 65536;
constexpr size_t WS_SGUW = WS_POOLW + 524288;
constexpr size_t WS_WIN = 4 * MiB;
constexpr size_t WS_WOUT = WS_WIN + (size_t)DEPTH * INW * DM * 2;
constexpr size_t WS_WGU = WS_WOUT + (size_t)DEPTH * DM * DM * 2;
constexpr size_t WS_WDN = WS_WGU + (size_t)DEPTH * 2 * DFF * DM * 2;
constexpr size_t WS_X = WS_WDN + (size_t)DEPTH * DM * DFF * 2;
constexpr size_t WS_A = WS_X + (size_t)MT * DM * 4;
constexpr size_t WS_P = WS_A + (size_t)MT * DM * 2;
constexpr size_t WS_MIX = WS_P + (size_t)MT * INW * 2;
constexpr size_t WS_ACT = WS_MIX + (size_t)MT * DM * 2;
constexpr size_t WS_SLAB = WS_ACT + (size_t)MT * DFF * 2;
constexpr size_t WS_END = WS_SLAB + (size_t)8 * MC * DM * 4;
constexpr int CW_BAR = 4096;
constexpr int CW_Q = 8192;
constexpr int NCH_P2 = 250;
constexpr int RING_OFF = 0, RING_BYTES = 131072;
constexpr int LDSCTL_OFF = RING_BYTES, MISC_OFF = LDSCTL_OFF + 320;
constexpr int LDS_BYTES = 147456;

#define GAS __attribute__((address_space(1)))
#define LAS __attribute__((address_space(3)))
typedef unsigned short bf16;
typedef unsigned v4u __attribute__((ext_vector_type(4)));
typedef float f32x4 __attribute__((ext_vector_type(4)));
typedef short bf16x8 __attribute__((ext_vector_type(8)));
typedef GAS unsigned gu32;
typedef GAS unsigned long long gu64;
#define RLX_AGENT __ATOMIC_RELAXED, __HIP_MEMORY_SCOPE_AGENT
#define LDS_WAIT() asm volatile("s_waitcnt lgkmcnt(0)" ::: "memory")
#define VM_WAIT() asm volatile("s_waitcnt vmcnt(0)" ::: "memory")
__device__ __forceinline__ unsigned long long rt() { return __builtin_amdgcn_s_memrealtime(); }
__device__ __forceinline__ unsigned f2bf(float f) { unsigned u = __builtin_bit_cast(unsigned, f); return (u + 0x7fffu + ((u >> 16) & 1u)) >> 16; }
__device__ __forceinline__ unsigned pk2(float lo, float hi) { return f2bf(lo) | (f2bf(hi) << 16); }

#define XB_TMO      128
#define XB_XCNT(j)  (256  + 64 * (j))
#define XB_XSUB(j)  (1280 + 64 * (j))
#define XB_XGEN(j)  (2304 + 64 * (j))
#define XB_TOP      3328
#define XB_TOPGEN   3392
#define XCD_BAR_WORDS 3456
#define XB_SPIN_CAP (1u << 18)

__device__ __forceinline__ unsigned xb_ld(unsigned* p)              { return __hip_atomic_load(p, __ATOMIC_RELAXED, __HIP_MEMORY_SCOPE_AGENT); }
__device__ __forceinline__ unsigned xb_add(unsigned* p, unsigned v) { return __hip_atomic_fetch_add(p, v, __ATOMIC_RELAXED, __HIP_MEMORY_SCOPE_AGENT); }
__device__ __forceinline__ unsigned xb_xcc_id() { return (unsigned)__builtin_amdgcn_s_getreg((3 << 11) | 20) & 0xFu; }
#define XB_SPIN(cond, bar) do { unsigned _sp = 0; while (cond) { __builtin_amdgcn_s_sleep(1); \
    if ((++_sp & 255u) == 0u) { if (xb_ld(&(bar)[XB_TMO])) break; if (_sp > XB_SPIN_CAP) { atomicAdd(&(bar)[XB_TMO], 1u); break; } } } } while (0)

struct XcdBarrier {
    unsigned* bar; unsigned x;
    volatile LAS unsigned* st;
};

__device__ __forceinline__ XcdBarrier xcd_barrier_post(unsigned* bar, volatile LAS unsigned* st) {
    XcdBarrier b; b.bar = bar; b.x = xb_xcc_id(); b.st = st;
    if (threadIdx.x == 0) (void)xb_add(&bar[XB_XCNT(b.x)], 1u);
    return b;
}
__device__ __forceinline__ void xcd_barrier_complete(unsigned* bar, unsigned x, unsigned& nloc, unsigned& nx) {
    const unsigned G = gridDim.x * gridDim.y * gridDim.z;
    unsigned sum, cnt, mine, sp = 0u;
    for (;;) {
        sum = 0u; cnt = 0u; mine = 0u;
#pragma unroll
        for (unsigned j = 0; j < 16; ++j) { const unsigned c = xb_ld(&bar[XB_XCNT(j)]); sum += c; cnt += (c > 0u) ? 1u : 0u; mine = (j == x) ? c : mine; }
        if (sum == G) break;
        __builtin_amdgcn_s_sleep(1);
        if ((++sp & 255u) == 0u) { if (xb_ld(&bar[XB_TMO])) break; if (sp > XB_SPIN_CAP) { atomicAdd(&bar[XB_TMO], 1u); break; } }
    }
    nloc = mine > 0u ? mine : 1u; nx = cnt > 0u ? cnt : 1u;
}

__device__ __forceinline__ void xcd_barrier(const XcdBarrier& b) {
    asm volatile("s_waitcnt vmcnt(0)" ::: "memory");
    __syncthreads();
    if (threadIdx.x == 0) {
        unsigned* bar = b.bar;
        __builtin_amdgcn_s_waitcnt(0);
        unsigned nloc = b.st[0], nx = b.st[1];
        if (nloc == 0u) { xcd_barrier_complete(bar, b.x, nloc, nx); b.st[0] = nloc; b.st[1] = nx; }
        const unsigned old = xb_add(&bar[XB_XSUB(b.x)], 1u);
        const unsigned gen = old / nloc;
        if (old + 1u == (gen + 1u) * nloc) {
            __builtin_amdgcn_fence(__ATOMIC_RELEASE, "agent");
            asm volatile("s_waitcnt vmcnt(0)" ::: "memory");
            const unsigned og = xb_add(&bar[XB_TOP], 1u);
            const unsigned tg = og / nx;
            if (og + 1u == (tg + 1u) * nx) xb_add(&bar[XB_TOPGEN], 1u);
            else XB_SPIN(xb_ld(&bar[XB_TOPGEN]) == tg, bar);
            __builtin_amdgcn_fence(__ATOMIC_ACQUIRE, "agent");
            xb_add(&bar[XB_XGEN(b.x)], 1u);
            asm volatile("s_waitcnt vmcnt(0)" ::: "memory");
        } else {
            XB_SPIN(xb_ld(&bar[XB_XGEN(b.x)]) == gen, bar);
            __builtin_amdgcn_fence(__ATOMIC_ACQUIRE, "agent");
            asm volatile("s_waitcnt vmcnt(0)" ::: "memory");
        }
    }
    __syncthreads();
}
#ifndef PRO_LAYERS
#define PRO_LAYERS 1
#endif
struct Params { const float* in[19]; float* out; unsigned char* ws; };
struct Frame { LAS unsigned char* lds; int tid, lane, wave, G, gw, NGW; };
__device__ __forceinline__ Frame mkframe(LAS unsigned char* lds) { Frame F; int t = threadIdx.x; asm volatile("" : "+v"(t)); F.lds = lds; F.tid = t; F.lane = t & 63; F.wave = __builtin_amdgcn_readfirstlane(t >> 6);
    F.G = gridDim.x; F.gw = blockIdx.x * NWAVES + F.wave; F.NGW = F.G * NWAVES; return F; }

__device__ __forceinline__ float wave_sum(float v) {
#pragma unroll
    for (int o = 1; o < 64; o <<= 1) v += __shfl_xor(v, o);
    return v;
}
__device__ __forceinline__ void transpose_item(const float* W, int K, int N, bf16* WT, int k0, int n0, int prow0, LAS float* scr, int lane) {
    const int lk = lane >> 3, ln = (lane & 7) * 4;
    f32x4 v[8];
#pragma unroll
    for (int i = 0; i < 8; ++i) v[i] = __builtin_nontemporal_load((const f32x4*)(W + (size_t)(k0 + 8 * i + lk) * N + n0 + ln));
#pragma unroll
    for (int i = 0; i < 8; ++i) { LAS float* d = scr + (8 * i + lk) * 33 + ln; d[0] = v[i].x; d[1] = v[i].y; d[2] = v[i].z; d[3] = v[i].w; }
    LDS_WAIT(); asm volatile("" ::: "memory");
    const int c = lane & 7;
#pragma unroll
    for (int j = 0; j < 4; ++j) { const int n = (lane >> 3) + 8 * j; const LAS float* s = scr + (8 * c) * 33 + n;
        v4u o; o.x = pk2(s[0 * 33], s[1 * 33]); o.y = pk2(s[2 * 33], s[3 * 33]); o.z = pk2(s[4 * 33], s[5 * 33]); o.w = pk2(s[6 * 33], s[7 * 33]);
        *(GAS v4u*)(WT + (size_t)(prow0 + n) * K + k0 + 8 * c) = o; }
    LDS_WAIT(); asm volatile("" ::: "memory");
}
__device__ __forceinline__ float silu_f(float x) { return x / (1.0f + __expf(-x)); }

constexpr int I_IN = (DM / 64) * (INW / 32), I_OUT = (DM / 64) * (DM / 32), I_GU = (DM / 64) * (2 * DFF / 32), I_DN = (DFF / 64) * (DM / 32), I_L = I_IN + I_OUT + I_GU + I_DN;
constexpr int NCH_A = 192, NCH_T = I_L / 32, NCH = NCH_A + NCH_T;
static_assert(I_L % 32 == 0, "whole chunks");
template <class PP> __device__ __forceinline__ void prep_chunk(const Frame& F, PP p, int l, int ch) {
    unsigned char* ws = p->ws; const int lane = F.lane;
    if (ch < NCH_A) {
        const int nc = ch % 48, kg = ch / 48, k0 = (kg * 8 + F.wave) * 64, n0 = nc * 256 + 4 * lane;
        const float* c = p->in[1]; const float* cc = p->in[3];
        float sv[5];
#pragma unroll
        for (int v = 0; v < 4; ++v) sv[v] = silu_f(c[v * DM + k0 + lane]);
        sv[4] = silu_f(cc[k0 + lane]);
        f32x4 acc[5];
#pragma unroll
        for (int v = 0; v < 5; ++v) acc[v] = (f32x4){0.f, 0.f, 0.f, 0.f};
        const float* wp = p->in[4] + ((size_t)l * DM + k0) * 12288 + n0;
#pragma unroll 8
        for (int kk = 0; kk < 64; ++kk) { const f32x4 w = __builtin_nontemporal_load((const f32x4*)(wp + (size_t)kk * 12288));
#pragma unroll
            for (int v = 0; v < 5; ++v) { const float s = __uint_as_float(__builtin_amdgcn_readlane(__float_as_uint(sv[v]), kk)); acc[v] += w * s; } }
        LAS float* red = (LAS float*)(F.lds + RING_OFF);
#pragma unroll
        for (int v = 0; v < 5; ++v) *(LAS f32x4*)(red + (F.wave * 5 + v) * 256 + 4 * lane) = acc[v];
        LDS_WAIT(); __syncthreads();
        float* mod = (float*)(ws + WS_MOD) + (size_t)l * 5 * 12288; const float* bada = p->in[5] + (size_t)l * 12288;
        for (int o = F.tid; o < 1280; o += 512) { const int v = o >> 8, cidx = o & 255; float s = 0.f;
#pragma unroll
            for (int w = 0; w < 8; ++w) s += red[(w * 5 + v) * 256 + cidx];
            if (kg == 0) s += bada[nc * 256 + cidx];
            unsafeAtomicAdd(mod + v * 12288 + nc * 256 + cidx, s); }
        __syncthreads();
        return;
    }
    LAS float* scr = (LAS float*)(F.lds + RING_OFF + F.wave * 16384);
#pragma unroll 1
    for (int i = 0; i < 4; ++i) {
        int r = (ch - NCH_A) * 32 + i * 8 + F.wave;
        if (r < I_IN) { const int nblk = INW / 32, k0 = (r / nblk) * 64, n0 = (r % nblk) * 32; int prow = n0;
            if (n0 < C_V) { const int t = n0 >> 8, rem = n0 & 255, hl = rem >> 7, ax = (rem >> 6) & 1, bj = (rem >> 5) & 1; prow = t * 256 + bj * 128 + hl * 64 + ax * 32; }
            transpose_item(p->in[8] + (size_t)l * DM * INW, DM, INW, (bf16*)(ws + WS_WIN) + (size_t)l * INW * DM, k0, n0, prow, scr, lane); continue; } r -= I_IN;
        if (r < I_OUT) { const int nblk = DM / 32, k0 = (r / nblk) * 64, n0 = (r % nblk) * 32;
            transpose_item(p->in[15] + (size_t)l * DM * DM, DM, DM, (bf16*)(ws + WS_WOUT) + (size_t)l * DM * DM, k0, n0, n0, scr, lane); continue; } r -= I_OUT;
        if (r < I_GU) { const int nblk = 2 * DFF / 32, k0 = (r / nblk) * 64, n0 = (r % nblk) * 32; const int bj = n0 >= DFF ? 1 : 0, cidx = n0 - bj * DFF, prow = (cidx >> 7) * 256 + bj * 128 + (cidx & 127);
            transpose_item(p->in[16] + (size_t)l * DM * 2 * DFF, DM, 2 * DFF, (bf16*)(ws + WS_WGU) + (size_t)l * 2 * DFF * DM, k0, n0, prow, scr, lane); continue; } r -= I_GU;
        { const int nblk = DM / 32, k0 = (r / nblk) * 64, n0 = (r % nblk) * 32;
            transpose_item(p->in[17] + (size_t)l * DFF * DM, DFF, DM, (bf16*)(ws + WS_WDN) + (size_t)l * DM * DFF, k0, n0, n0, scr, lane); }
    }
}
template <class PP> __device__ __forceinline__ void steal_prep(const Frame& F, PP p, int l, gu32* q, int lo, int hi, volatile LAS unsigned* tick) {
    for (;;) {
        if (F.tid == 0) tick[0] = (unsigned)lo + __hip_atomic_fetch_add(q, 1u, __ATOMIC_RELAXED, __HIP_MEMORY_SCOPE_AGENT);
        LDS_WAIT(); __syncthreads();
        const int ch = (int)tick[0];
        __syncthreads();
        if (ch >= hi) break;
        prep_chunk(F, p, l, ch);
    }
}
template <class PP> __device__ __forceinline__ void prologue(const Frame& F, PP p) {
    unsigned char* ws = p->ws; const int lane = F.lane;
    _Pragma("nounroll") for (int l = 0; l < PRO_LAYERS; ++l)
        for (int ch = blockIdx.x; ch < NCH; ch += F.G) prep_chunk(F, p, l, ch);
    {
        LAS float* scr = (LAS float*)(F.lds + RING_OFF + F.wave * 16384);
        for (int r = F.gw; r < 16 * 8; r += F.NGW) { const int mat = r >> 3, q = r & 7, k0 = (q >> 2) * 64, n0 = (q & 3) * 32;
            transpose_item(p->in[10] + (size_t)mat * 16384, 128, 128, (bf16*)(ws + WS_POOLW) + (size_t)mat * 16384, k0, n0, n0, scr, lane); }
    }
    {
        const int gt = F.gw * 64 + lane, NT = F.NGW * 64;
        const float* sw = p->in[13]; bf16* so = (bf16*)(ws + WS_SGUW);
        for (int i = gt; i < DEPTH * 4 * 128 * 128 / 2; i += NT) ((unsigned*)so)[i] = pk2(sw[2 * i], sw[2 * i + 1]);
        float* rope = (float*)(ws + WS_ROPE);
        for (int i = gt; i < 2048; i += NT) { const int pos = i >> 5, fi = i & 31; const float inv = powf(10000.0f, -(float)(2 * fi) / 64.0f), ang = (float)pos * inv;
            rope[i] = cosf(ang); rope[2048 + i] = sinf(ang); }
    }
}

__device__ __forceinline__ void norm_phase(const Frame& F, const float* xlat, const float* xctx, const float* g, const float* modl, int shift_idx, int scale_idx, bf16* A, int nrows,
                                           const float* slab, const float* rgate, float* xw) {
    for (int row = F.gw; row < nrows; row += F.NGW) {
        const bool lat = row < ML; const int bidx = lat ? (row >> 11) : 4;
        const float* src = lat ? xlat + (size_t)row * DM : xctx + (size_t)(row - ML) * DM;
        const GAS f32x4* xr = (const GAS f32x4*)src + F.lane;
        f32x4 v[8];
#pragma unroll
        for (int j = 0; j < 8; ++j) v[j] = xr[64 * j];
        if (!lat && slab) {
            const GAS f32x4* sp = (const GAS f32x4*)(slab + (size_t)(row - ML) * DM) + F.lane; const GAS f32x4* gp = (const GAS f32x4*)rgate + F.lane;
            GAS f32x4* wp = (GAS f32x4*)(xw + (size_t)(row - ML) * DM) + F.lane;
#pragma unroll
            for (int j = 0; j < 8; ++j) { f32x4 s = sp[64 * j];
#pragma unroll
                for (int k = 1; k < 8; ++k) s += sp[(size_t)k * (MC * DM / 4) + 64 * j];
                v[j] = v[j] + gp[64 * j] * s; wp[64 * j] = v[j]; }
        }
        float ss = 0.f;
#pragma unroll
        for (int j = 0; j < 8; ++j) ss += (v[j].x * v[j].x + v[j].y * v[j].y) + (v[j].z * v[j].z + v[j].w * v[j].w);
        const float rstd = 1.0f / sqrtf(wave_sum(ss) * (1.0f / DM) + EPS);
        const GAS f32x4* gp = (const GAS f32x4*)g + F.lane;
        const GAS f32x4* shp = (const GAS f32x4*)(modl + bidx * 12288 + shift_idx * DM) + F.lane;
        const GAS f32x4* scp = (const GAS f32x4*)(modl + bidx * 12288 + scale_idx * DM) + F.lane;
        GAS unsigned long long* o8 = (GAS unsigned long long*)(A + (size_t)row * DM) + F.lane;
#pragma unroll
        for (int j = 0; j < 8; ++j) { const f32x4 gg = gp[64 * j], sh = shp[64 * j], sc = scp[64 * j];
            const f32x4 h = (v[j] * rstd * gg) * (sc + 1.0f) + sh;
            o8[64 * j] = (unsigned long long)pk2(h.x, h.y) | ((unsigned long long)pk2(h.z, h.w) << 32); }
    }
}
__device__ __forceinline__ void final_norm(const Frame& F, const float* X, const float* g, float* out) {
    for (int row = F.gw; row < ML; row += F.NGW) {
        const GAS f32x4* xr = (const GAS f32x4*)(X + (size_t)row * DM) + F.lane;
        f32x4 v[8]; float ss = 0.f;
#pragma unroll
        for (int j = 0; j < 8; ++j) { v[j] = xr[64 * j]; ss += (v[j].x * v[j].x + v[j].y * v[j].y) + (v[j].z * v[j].z + v[j].w * v[j].w); }
        const float rstd = 1.0f / sqrtf(wave_sum(ss) * (1.0f / DM) + EPS);
        const GAS f32x4* gp = (const GAS f32x4*)g + F.lane; GAS f32x4* op = (GAS f32x4*)(out + (size_t)row * DM) + F.lane;
#pragma unroll
        for (int j = 0; j < 8; ++j) op[64 * j] = v[j] * rstd * gp[64 * j];
    }
}

template <int HALF> __device__ __forceinline__ void pool_wave(const Frame& F, const bf16* P, bf16* MIX, const bf16* bt  , const float* pscale  , int row0, int gcol) {
    const int lane = F.lane; const bool lat = row0 < ML;
    const int S = lat ? SEQ : CTXL, seqbase = lat ? (row0 & ~(SEQ - 1)) : ML + ((row0 - ML) & ~(CTXL - 1)), t0 = row0 - seqbase;
    constexpr int NR = 32 + 2 * HALF;
    unsigned raw[NR];
#pragma unroll
    for (int r = 0; r < NR; ++r) { const int t = t0 - HALF + r; raw[r] = (t >= 0 && t < S) ? *(const GAS unsigned*)(P + (size_t)(seqbase + t) * INW + C_POOL + gcol + 2 * lane) : 0u; }
    LAS unsigned char* img = F.lds + RING_OFF + F.wave * 16384;
    float s0 = 0.f, s1 = 0.f;
#pragma unroll
    for (int r = 0; r < 2 * HALF; ++r) { s0 += __uint_as_float(raw[r] << 16); s1 += __uint_as_float(raw[r] & 0xffff0000u); }
#pragma unroll
    for (int i = 0; i < 32; ++i) {
        const int t = t0 + i, lo = t - HALF < 0 ? 0 : t - HALF, hi = t + HALF > S ? S : t + HALF; const float inv = 1.0f / (float)(hi - lo);
        const float p0 = s0 * inv - __uint_as_float(raw[i + HALF] << 16), p1 = s1 * inv - __uint_as_float(raw[i + HALF] & 0xffff0000u);
        *(LAS unsigned*)(img + i * 256 + ((((lane >> 2) ^ (i & 7)) << 4) | ((lane & 3) << 2))) = pk2(p0, p1);
        s0 += __uint_as_float(raw[i + 2 * HALF] << 16) - __uint_as_float(raw[i] << 16); s1 += __uint_as_float(raw[i + 2 * HALF] & 0xffff0000u) - __uint_as_float(raw[i] & 0xffff0000u);
    }
    LDS_WAIT(); __builtin_amdgcn_wave_barrier();
    const int fr = lane & 15, fq = lane >> 4;
    f32x4 acc[2][8];
#pragma unroll
    for (int m = 0; m < 2; ++m)
#pragma unroll
        for (int nb = 0; nb < 8; ++nb) acc[m][nb] = (f32x4){0.f, 0.f, 0.f, 0.f};
#pragma unroll
    for (int ks = 0; ks < 4; ++ks) {
        bf16x8 a[2], b[8];
#pragma unroll
        for (int nb = 0; nb < 8; ++nb) b[nb] = *(const GAS bf16x8*)(bt + (nb * 16 + fr) * 128 + ks * 32 + fq * 8);
#pragma unroll
        for (int m = 0; m < 2; ++m) { const int row = m * 16 + fr; a[m] = *(const LAS bf16x8*)(img + row * 256 + (((ks * 4 + fq) ^ (row & 7)) << 4)); }
#pragma unroll
        for (int m = 0; m < 2; ++m)
#pragma unroll
            for (int nb = 0; nb < 8; ++nb) acc[m][nb] = __builtin_amdgcn_mfma_f32_16x16x32_bf16(b[nb], a[m], acc[m][nb], 0, 0, 0);
    }
#pragma unroll
    for (int nb = 0; nb < 8; ++nb) { const int d = nb * 16 + 4 * fq; const f32x4 sc = *(const f32x4*)(pscale + d);
#pragma unroll
        for (int m = 0; m < 2; ++m) { const f32x4 o = acc[m][nb] * sc;
            *(GAS unsigned long long*)(MIX + (size_t)(row0 + m * 16 + fr) * DM + 1024 + gcol + d) = (unsigned long long)pk2(o.x, o.y) | ((unsigned long long)pk2(o.z, o.w) << 32); } }
    LDS_WAIT(); __builtin_amdgcn_wave_barrier();
}
constexpr int LP = 136;
__device__ __forceinline__ void sgu_half(const Frame& F, const bf16* P, bf16* MIX, const bf16* sguw  , const float* normg  , const float* sb  , int item, bool active) {
    const int half = F.wave >> 2, hw = F.wave & 3, th = F.tid & 255, lane = F.lane;
    LAS bf16* Bs = (LAS bf16*)(F.lds + RING_OFF) + half * 128 * LP;
    const int tt = item >> 2, g = item & 3, row0 = tt * 128;
    if (active) {
        const int q = th >> 1, part = th & 1; const bf16* zp = P + (size_t)(row0 + q) * INW + C_Z + g * 128 + part * 64;
        float z[64];
#pragma unroll
        for (int i = 0; i < 8; ++i) { const v4u w = *(const GAS v4u*)(zp + 8 * i);
#pragma unroll
            for (int j = 0; j < 4; ++j) { z[8 * i + 2 * j] = __uint_as_float(w[j] << 16); z[8 * i + 2 * j + 1] = __uint_as_float(w[j] & 0xffff0000u); } }
        float s = 0.f;
#pragma unroll
        for (int i = 0; i < 64; ++i) s += z[i];
        s += __shfl_xor(s, 1);
        const float mu = s * (1.0f / 128.0f); float q2 = 0.f;
#pragma unroll
        for (int i = 0; i < 64; ++i) { z[i] -= mu; q2 += z[i] * z[i]; }
        q2 += __shfl_xor(q2, 1);
        const float rstd = 1.0f / sqrtf(q2 * (1.0f / 128.0f) + EPS);
        const float* ng = normg + g * 128 + part * 64;
#pragma unroll
        for (int i = 0; i < 64; ++i) Bs[(part * 64 + i) * LP + q] = (bf16)f2bf(z[i] * rstd * ng[i]);
    }
    LDS_WAIT(); __syncthreads();
    if (active) {
        const int fr = lane & 15, fq = lane >> 4;
        f32x4 acc[2][8];
#pragma unroll
        for (int m = 0; m < 2; ++m)
#pragma unroll
            for (int nb = 0; nb < 8; ++nb) acc[m][nb] = (f32x4){0.f, 0.f, 0.f, 0.f};
        const bf16* ap = sguw + (size_t)g * 16384 + (hw * 32 + fr) * 128 + fq * 8;
#pragma unroll
        for (int ks = 0; ks < 4; ++ks) {
            bf16x8 a[2], b[8];
#pragma unroll
            for (int m = 0; m < 2; ++m) a[m] = *(const GAS bf16x8*)(ap + m * 16 * 128 + ks * 32);
#pragma unroll
            for (int nb = 0; nb < 8; ++nb) b[nb] = *(const LAS bf16x8*)(Bs + (nb * 16 + fr) * LP + ks * 32 + fq * 8);
#pragma unroll
            for (int m = 0; m < 2; ++m)
#pragma unroll
                for (int nb = 0; nb < 8; ++nb) acc[m][nb] = __builtin_amdgcn_mfma_f32_16x16x32_bf16(b[nb], a[m], acc[m][nb], 0, 0, 0);
        }
#pragma unroll
        for (int m = 0; m < 2; ++m) { const int pr = hw * 32 + m * 16 + fr, r = row0 + pr; const float bias = sb[g * 128 + pr];
#pragma unroll
            for (int nb = 0; nb < 8; ++nb) { const int c = nb * 16 + 4 * fq;
                const unsigned long long uw = *(const GAS unsigned long long*)(P + (size_t)r * INW + C_U + g * 128 + c);
                const unsigned ulo = (unsigned)uw, uhi = (unsigned)(uw >> 32);
                const f32x4 gu = (f32x4){__uint_as_float(ulo << 16), __uint_as_float(ulo & 0xffff0000u), __uint_as_float(uhi << 16), __uint_as_float(uhi & 0xffff0000u)};
                const f32x4 o = gu * (acc[m][nb] + bias);
                *(GAS unsigned long long*)(MIX + (size_t)r * DM + 1536 + g * 128 + c) = (unsigned long long)pk2(o.x, o.y) | ((unsigned long long)pk2(o.z, o.w) << 32); } }
    }
    __syncthreads();
}

#ifndef REP_P1
#define REP_P1 1
#endif
#ifndef REP_P2
#define REP_P2 1
#endif
#ifndef REP_P3a
#define REP_P3a 1
#endif
#ifndef REP_P3b
#define REP_P3b 1
#endif
#ifndef REP_P4
#define REP_P4 1
#endif
#ifndef REP_P5
#define REP_P5 1
#endif
#ifndef REP_P6
#define REP_P6 1
#endif
#ifndef REP_P7
#define REP_P7 1
#endif
typedef const Params __attribute__((address_space(4))) KParams;
__device__ __forceinline__ KParams* kparams() { KParams* q = (KParams*)__builtin_amdgcn_kernarg_segment_ptr(); asm volatile("" : "+s"(q)); return q; }
__global__ void __launch_bounds__(NWAVES * 64, 2) fwd_kernel(Params p_unused) {
    extern __shared__ __attribute__((aligned(16))) unsigned char lds[];
    for (int u = threadIdx.x; u < (LDS_BYTES - LDSCTL_OFF) / 4; u += NWAVES * 64) ((LAS unsigned*)((LAS unsigned char*)lds + LDSCTL_OFF))[u] = 0u;
    __syncthreads();
    volatile LAS unsigned* MISC = (volatile LAS unsigned*)((LAS unsigned char*)lds + MISC_OFF);
    XcdBarrier bar;
    { KParams* kp = kparams(); const Frame F = mkframe((LAS unsigned char*)lds); bar = xcd_barrier_post((unsigned*)((gu32*)(kp->ws + WS_CTL) + CW_BAR), MISC + 8); }
#define GRID_BAR() xcd_barrier(bar)

    { KParams* kp = kparams(); const Frame F = mkframe((LAS unsigned char*)lds); prologue(F, kp); }
    GRID_BAR();

    for (int l = 0; l < DEPTH; ++l) {
        const bool last = (l == DEPTH - 1);
        const int Mrows = last ? ML : MT;
#ifndef NO_P1
        _Pragma("nounroll") for (int rep = 0; rep < REP_P1; ++rep) {
        { KParams* kp = kparams(); const Frame F = mkframe((LAS unsigned char*)lds); unsigned char* ws = kp->ws; float* X = (float*)(ws + WS_X); const float* mod = (const float*)(ws + WS_MOD);
          norm_phase(F, l == 0 ? kp->in[0] : X, l == 0 ? kp->in[2] : X + (size_t)ML * DM, kp->in[6] + (size_t)l * DM, mod + (size_t)l * 5 * 12288, 0, 1, (bf16*)(ws + WS_A), MT,
                     (l == 0 || rep + 1 < REP_P1) ? nullptr : (const float*)(ws + WS_SLAB), mod + (size_t)(l - 1) * 5 * 12288 + 4 * 12288 + 5 * DM, X + (size_t)ML * DM); }
        GRID_BAR(); }
#else
        GRID_BAR();
#endif
#ifndef NO_P2
        _Pragma("nounroll") for (int rep = 0; rep < REP_P2; ++rep) {
        { KParams* kp = kparams(); const Frame F = mkframe((LAS unsigned char*)lds); unsigned char* ws = kp->ws;
          pg8::Gemm g{(const bf16*)(ws + WS_A), (const bf16*)(ws + WS_WIN) + (size_t)l * INW * DM, MT, INW, DM}; pg8::StaticOrder S; S.init(MT, INW, F.G, (int)blockIdx.x, DM);
          pg8::EpiIn E{(bf16*)(ws + WS_P), (const float*)(ws + WS_ROPE)};
          pg8::gemm_phase<pg8::EpiIn, pg8::StaticOrder, true, true>(F.lds + RING_OFF, g, S, E);
          if (PRO_LAYERS == 1 && !last) steal_prep(F, kp, l + 1, (gu32*)(ws + WS_CTL) + CW_Q + (2 * l) * 64, 0, NCH_P2, (volatile LAS unsigned*)(F.lds + MISC_OFF)); }
        GRID_BAR(); }
#else
        GRID_BAR();
#endif
#ifndef NO_P3a
        _Pragma("nounroll") for (int rep = 0; rep < REP_P3a; ++rep) {
        { KParams* kp = kparams(); const Frame F = mkframe((LAS unsigned char*)lds); unsigned char* ws = kp->ws; const bf16* P = (const bf16*)(ws + WS_P); bf16* MIX = (bf16*)(ws + WS_MIX);
          const float* sink = kp->in[9] + l * 8;
          const int natt = last ? 256 : (F.G == 256 ? 512 : 288);
          for (int it0 = blockIdx.x; it0 < natt; it0 += F.G) {
              int it = it0;
              if (F.G == 256 && it0 >= 256) { const int c = it0 - 256, rem = c & 63; if (rem >= 4 && rem < 60) continue; it = 256 + (c >> 6) * 8 + (rem < 4 ? rem : rem - 56); }
              int qrow0w, qh, hk, rqw, nloc, jl0, kloc0, kctx0;
              if (it < 256) {
                  const int b = it >> 6, rem = it & 63, nq = rem >> 2, pair = rem & 1; hk = (rem >> 1) & 1;
                  qh = hk * 4 + pair * 2 + (F.wave >> 2); rqw = (F.wave & 3) * 32; jl0 = nq == 0 ? 2 : 0; nloc = (nq == 15 ? 3 : 5) - jl0 + 1;
                  qrow0w = b * SEQ + nq * 128 + rqw; kloc0 = b * SEQ + (nq - 1) * 128 + 64 * jl0; kctx0 = ML + b * CTXL;
              } else {
                  const int u = it - 256, b = u >> 3; qh = u & 7; hk = qh >> 2; rqw = 0; nloc = 0; jl0 = 2; kloc0 = 0; kctx0 = ML + b * CTXL; qrow0w = kctx0 + F.wave * 32;
              }
              att::attn_unit(P, MIX, qrow0w, qh, hk, rqw, sink[qh], nloc, jl0, kloc0, kctx0, (char*)lds + RING_OFF);
          } }
        if (rep + 1 < REP_P3a) GRID_BAR(); }
#endif
#ifndef NO_P3b
        _Pragma("nounroll") for (int rep = 0; rep < REP_P3b; ++rep) {
        { KParams* kp = kparams(); const Frame F = mkframe((LAS unsigned char*)lds); unsigned char* ws = kp->ws; const bf16* P = (const bf16*)(ws + WS_P); bf16* MIX = (bf16*)(ws + WS_MIX);
          const int nsgu = (last ? 64 : 72) * 4; const bf16* sguw = (const bf16*)(ws + WS_SGUW) + (size_t)l * 4 * 16384;
          for (int base = 0; base < nsgu; base += 2 * F.G) { const int item = base + (F.wave >> 2) * F.G + (int)blockIdx.x;
              sgu_half(F, P, MIX, sguw, kp->in[12] + l * 512, kp->in[14] + l * 512, item, item < nsgu); } }
        { KParams* kp = kparams(); const Frame F = mkframe((LAS unsigned char*)lds); unsigned char* ws = kp->ws; const bf16* P = (const bf16*)(ws + WS_P); bf16* MIX = (bf16*)(ws + WS_MIX);
          const int nsub = (last ? ML : MT) / 32, npool = nsub * 4; const bf16* poolwt = (const bf16*)(ws + WS_POOLW) + (size_t)l * 4 * 16384; const float* pscale = kp->in[11] + l * 512;
          for (int i = F.NGW - 1 - F.gw; i < npool; i += F.NGW) {
              const int g = i / nsub, row0 = (i - g * nsub) * 32; const bf16* bt = poolwt + (size_t)g * 16384; const float* ps = pscale + g * 128;
              if (g == 0) pool_wave<1>(F, P, MIX, bt, ps, row0, 0); else if (g == 1) pool_wave<2>(F, P, MIX, bt, ps, row0, 128);
              else if (g == 2) pool_wave<4>(F, P, MIX, bt, ps, row0, 256); else pool_wave<8>(F, P, MIX, bt, ps, row0, 384);
          } }
        GRID_BAR(); }
#else
        GRID_BAR();
#endif
#ifndef NO_P4
        _Pragma("nounroll") for (int rep = 0; rep < REP_P4; ++rep) {
        { KParams* kp = kparams(); const Frame F = mkframe((LAS unsigned char*)lds); unsigned char* ws = kp->ws; float* X = (float*)(ws + WS_X);
          pg8::Gemm g{(const bf16*)(ws + WS_MIX), (const bf16*)(ws + WS_WOUT) + (size_t)l * DM * DM, MT, DM, DM}; pg8::SplitOrder<false> S; S.init(ML, DM, F.G, (int)blockIdx.x, DM); S.nsplit = last ? 0 : 256;
          pg8::EpiRes E{l == 0 ? kp->in[0] : X, (rep + 1 < REP_P4) ? (float*)(ws + WS_END) : X, (float*)(ws + WS_SLAB), (const float*)(ws + WS_MOD) + (size_t)l * 5 * 12288, 2};
          pg8::gemm_phase<pg8::EpiRes, pg8::SplitOrder<false>, true, true>(F.lds + RING_OFF, g, S, E); }
        GRID_BAR(); }
#else
        GRID_BAR();
#endif
#ifndef NO_P5
        _Pragma("nounroll") for (int rep = 0; rep < REP_P5; ++rep) {
        { KParams* kp = kparams(); const Frame F = mkframe((LAS unsigned char*)lds); unsigned char* ws = kp->ws; float* X = (float*)(ws + WS_X); const float* modl = (const float*)(ws + WS_MOD) + (size_t)l * 5 * 12288;
          norm_phase(F, X, l == 0 ? kp->in[2] : X + (size_t)ML * DM, kp->in[7] + (size_t)l * DM, modl, 3, 4, (bf16*)(ws + WS_A), Mrows, (rep + 1 < REP_P5) ? nullptr : (const float*)(ws + WS_SLAB), modl + 4 * 12288 + 2 * DM, X + (size_t)ML * DM); }
        GRID_BAR(); }
#else
        GRID_BAR();
#endif
#ifndef NO_P6
        _Pragma("nounroll") for (int rep = 0; rep < REP_P6; ++rep) {
        { KParams* kp = kparams(); const Frame F = mkframe((LAS unsigned char*)lds); unsigned char* ws = kp->ws;
          pg8::Gemm g{(const bf16*)(ws + WS_A), (const bf16*)(ws + WS_WGU) + (size_t)l * 2 * DFF * DM, Mrows, 2 * DFF, DM}; pg8::StaticOrder S; S.init(Mrows, 2 * DFF, F.G, (int)blockIdx.x, DM);
          pg8::EpiSwiglu E{(bf16*)(ws + WS_ACT)};
          pg8::gemm_phase<pg8::EpiSwiglu, pg8::StaticOrder, true, true>(F.lds + RING_OFF, g, S, E);
          if (PRO_LAYERS == 1 && !last) { steal_prep(F, kp, l + 1, (gu32*)(ws + WS_CTL) + CW_Q + (2 * l) * 64, 0, NCH_P2, (volatile LAS unsigned*)(F.lds + MISC_OFF));
              steal_prep(F, kp, l + 1, (gu32*)(ws + WS_CTL) + CW_Q + (2 * l + 1) * 64, NCH_P2, NCH, (volatile LAS unsigned*)(F.lds + MISC_OFF)); } }
        GRID_BAR(); }
#else
        GRID_BAR();
#endif
#ifndef NO_P7
        _Pragma("nounroll") for (int rep = 0; rep < REP_P7; ++rep) {
        { KParams* kp = kparams(); const Frame F = mkframe((LAS unsigned char*)lds); unsigned char* ws = kp->ws; float* X = (float*)(ws + WS_X);
          pg8::Gemm g{(const bf16*)(ws + WS_ACT), (const bf16*)(ws + WS_WDN) + (size_t)l * DM * DFF, MT, DM, DFF}; pg8::SplitOrder<true> S; S.init(ML, DM, F.G, (int)blockIdx.x, DFF); S.nsplit = last ? 0 : 256;
          pg8::EpiRes E{X, (rep + 1 < REP_P7) ? (float*)(ws + WS_END) : X, (float*)(ws + WS_SLAB), (const float*)(ws + WS_MOD) + (size_t)l * 5 * 12288, 5};
          pg8::gemm_phase<pg8::EpiRes, pg8::SplitOrder<true>, true, true>(F.lds + RING_OFF, g, S, E); }
        GRID_BAR(); }
#else
        GRID_BAR();
#endif
    }
    { KParams* kp = kparams(); const Frame F = mkframe((LAS unsigned char*)lds); final_norm(F, (const float*)(kp->ws + WS_X), kp->in[18], kp->out); }
}

extern "C" void kernel_launch(void* const* d_in, const int* in_sizes, int n_in, void* d_out, int out_size, void* d_ws, size_t ws_size, hipStream_t stream) {
    static int grid = 0;
    if (grid == 0) {
        if (n_in != 19 || out_size != ML * DM || ws_size < WS_END) { fprintf(stderr, "kernel_launch: unexpected shapes (n_in %d out %d ws %zu, need ws >= %zu)\n", n_in, out_size, ws_size, (size_t)WS_END); grid = -1; return; }
        int dev = 0, cus = 0, per_cu = 0;
        if (hipGetDevice(&dev) != hipSuccess || hipDeviceGetAttribute(&cus, hipDeviceAttributeMultiprocessorCount, dev) != hipSuccess) { grid = -1; return; }
        if (hipFuncSetAttribute((const void*)fwd_kernel, hipFuncAttributeMaxDynamicSharedMemorySize, LDS_BYTES) != hipSuccess) { fprintf(stderr, "kernel_launch: hipFuncSetAttribute failed\n"); grid = -1; return; }
        if (hipOccupancyMaxActiveBlocksPerMultiprocessor(&per_cu, (const void*)fwd_kernel, NWAVES * 64, LDS_BYTES) != hipSuccess || per_cu < 1) { fprintf(stderr, "kernel_launch: occupancy query says %d\n", per_cu); }
        (void)hipGetLastError();
        grid = cus;
    }
    if (grid < 0) return;
    if (hipMemsetAsync((char*)d_ws + WS_CTL, 0, CTL_ZERO_BYTES, stream) != hipSuccess) return;
    Params p{};
    for (int i = 0; i < 19; ++i) p.in[i] = (const float*)d_in[i];
    p.out = (float*)d_out; p.ws = (unsigned char*)d_ws;
    hipLaunchKernelGGL(fwd_kernel, dim3(grid), dim3(NWAVES * 64), LDS_BYTES, stream, p);
}
```
